# Optimizing an MI355X kernel written in HIP

```python
import math
import jax, jax.numpy as jnp
from jax import lax
import numpy as np

D_MODEL = 2048
BATCH = 16
SEQ = 2048
DEPTH = 2

GRID_W = 64
CTX_LEN = 256
MIX_W = D_MODEL
LIN_W = MIX_W // 2
POOL_W = MIX_W - LIN_W
N_LIN_HEADS = 8
HEAD_DIM = LIN_W // N_LIN_HEADS
N_DIR = 2
N_POOL_GROUPS = 4
POOL_GROUP_W = POOL_W // N_POOL_GROUPS
POOL_SIZES = (2, 4, 8, 16)
CONV_K = 5
CHUNK = 64
D_FF = 4 * D_MODEL
N_MOD = 6
GATE_START = 3 * LIN_W
DECAY_START = 4 * LIN_W
POOL_START = DECAY_START + 2 * N_DIR * N_LIN_HEADS
IN_COLS = POOL_START + POOL_W
EPS = 1e-6

kernel_name = 'hybrid_deltanet_pool_dit_block'


def rmsnorm(x, w):
    xf = x.astype(jnp.float32)
    y = xf * lax.rsqrt(jnp.mean(xf * xf, axis=-1, keepdims=True) + EPS)
    return y.astype(x.dtype) * w


def l2norm(x):
    xf = x.astype(jnp.float32)
    return (xf * lax.rsqrt(jnp.sum(xf * xf, axis=-1, keepdims=True) + EPS)).astype(x.dtype)


def modulate(xn, shift, scale):
    return xn * (1 + scale) + shift


def short_conv(u, w):
    t = u.shape[1]
    pad = CONV_K // 2
    up = jnp.pad(u, ((0, 0), (pad, pad), (0, 0)))
    out = up[:, 0:t] * w[0]
    for i in range(1, CONV_K):
        out = out + up[:, i:i + t] * w[i]
    return out


def gated_delta_chunked(q, k, v, g, beta, s0):
    b, t, h, dk = k.shape
    dv = v.shape[-1]
    n = t // CHUNK
    f32 = jnp.float32

    def to_chunks(a):
        a = a.astype(f32).reshape((b, n, CHUNK) + a.shape[2:])
        return jnp.moveaxis(a, (1, 2), (0, 3))

    kc, vc, gch, bc = to_chunks(k), to_chunks(v), to_chunks(g), to_chunks(beta)
    gcum = jnp.cumsum(gch, axis=-1)
    incl = jnp.tril(jnp.ones((CHUNK, CHUNK), dtype=bool))
    strict = jnp.tril(jnp.ones((CHUNK, CHUNK), dtype=bool), -1)
    diff = gcum[..., :, None] - gcum[..., None, :]
    decay = jnp.where(incl, jnp.exp(jnp.where(incl, diff, 0.0)), 0.0)
    kb = kc * bc[..., None]
    m = jnp.where(strict, jnp.einsum('nbhid,nbhjd->nbhij', kb, kc) * decay, 0.0)
    tmat = m + jnp.eye(CHUNK, dtype=f32)
    u = lax.linalg.triangular_solve(tmat, vc * bc[..., None], left_side=True, lower=True, unit_diagonal=True)
    w = lax.linalg.triangular_solve(tmat, kb * jnp.exp(gcum)[..., None], left_side=True, lower=True, unit_diagonal=True)
    g_last = gcum[..., -1]
    k_tail = kc * jnp.exp(g_last[..., None] - gcum)[..., None]
    if q is None:
        xs = (u, w, k_tail, g_last, None, None)
    else:
        qc = to_chunks(q)
        intra = jnp.einsum('nbhid,nbhjd->nbhij', qc, kc) * decay
        xs = (u, w, k_tail, g_last, qc * jnp.exp(gcum)[..., None], intra)

    def step(s, inp):
        u_i, w_i, kt_i, gl_i, qd_i, at_i = inp
        v_new = u_i - jnp.einsum('bhck,bhkv->bhcv', w_i, s)
        s_new = s * jnp.exp(gl_i)[..., None, None] + jnp.einsum('bhck,bhcv->bhkv', kt_i, v_new)
        if qd_i is None:
            return s_new, None
        o_i = jnp.einsum('bhck,bhkv->bhcv', qd_i, s) + jnp.einsum('bhij,bhjv->bhiv', at_i, v_new)
        return s_new, o_i

    s_fin, o = lax.scan(step, s0.astype(f32), xs)
    if o is None:
        return None, s_fin
    o = jnp.moveaxis(o, (0, 3), (1, 2)).reshape(b, t, h, dv).astype(v.dtype)
    return o, s_fin


def deltanet_inputs(proj, conv_w, a_log, dt_bias):
    b, t, _ = proj.shape
    qkv = jax.nn.silu(short_conv(proj[..., :GATE_START], conv_w)).reshape(b, t, 3, N_LIN_HEADS, HEAD_DIM)
    q = l2norm(qkv[:, :, 0]) * HEAD_DIM ** -0.5
    k = l2norm(qkv[:, :, 1])
    v = qkv[:, :, 2]
    z = proj[..., GATE_START:DECAY_START].reshape(b, t, N_LIN_HEADS, HEAD_DIM)
    ab = proj[..., DECAY_START:POOL_START].astype(jnp.float32).reshape(b, t, 2, N_DIR, N_LIN_HEADS)
    g = -jnp.exp(a_log.astype(jnp.float32)) * jax.nn.softplus(ab[:, :, 0] + dt_bias.astype(jnp.float32))
    beta = jax.nn.sigmoid(ab[:, :, 1])
    return q, k, v, z, g, beta


def gated_head_norm(o, z, w):
    return (rmsnorm(o, w) * jax.nn.silu(z)).reshape(o.shape[0], o.shape[1], LIN_W)


def flip_t(a):
    return jnp.flip(a, axis=1)


def box_mean(u, size, axis):
    n = u.shape[axis]
    idx = jnp.arange(n)
    lo = jnp.clip(idx - size // 2, 0, n - 1)
    hi = jnp.clip(idx + size - 1 - size // 2, 0, n - 1)
    pad = [(0, 0)] * u.ndim
    pad[axis] = (1, 0)
    csum = jnp.pad(jnp.cumsum(u.astype(jnp.float32), axis=axis), pad)
    total = jnp.take(csum, hi + 1, axis=axis) - jnp.take(csum, lo, axis=axis)
    shape = [1] * u.ndim
    shape[axis] = n
    cnt = (hi - lo + 1).astype(jnp.float32).reshape(shape)
    return (total / cnt).astype(u.dtype)


def pool_mixer(p, pool_w, pool_scale, on_grid):
    b, t, _ = p.shape
    outs = []
    for gi, size in enumerate(POOL_SIZES):
        pg = p[..., gi * POOL_GROUP_W:(gi + 1) * POOL_GROUP_W]
        if on_grid:
            rows = t // GRID_W
            pg2 = pg.reshape(b, rows, GRID_W, POOL_GROUP_W)
            mean = box_mean(box_mean(pg2, size, 1), size, 2).reshape(b, t, POOL_GROUP_W)
        else:
            mean = box_mean(pg, size, 1)
        outs.append((mean - pg) @ pool_w[gi])
    return jnp.concatenate(outs, axis=-1) * pool_scale


def sq_relu_mlp(xn, w_up, w_down):
    return jnp.square(jax.nn.relu(xn @ w_up)) @ w_down


def trunk_layer(x, h, mod, mod_c, norm1_w, norm2_w, w_in, conv_w, a_log, dt_bias, onorm_w,
                pool_w, pool_scale, w_out, w_up, w_down, ctx_out):
    b = x.shape[0]
    xn = modulate(rmsnorm(x, norm1_w), mod[..., 0, :], mod[..., 1, :])
    hn = modulate(rmsnorm(h, norm1_w), mod_c[..., 0, :], mod_c[..., 1, :])
    px = xn @ w_in
    ph = hn @ w_in

    qx, kx, vx, zx, gx, bx = deltanet_inputs(px, conv_w, a_log, dt_bias)
    qh, kh, vh, zh, gh, bh = deltanet_inputs(ph, conv_w, a_log, dt_bias)
    s0 = jnp.zeros((b, N_LIN_HEADS, HEAD_DIM, HEAD_DIM), jnp.float32)
    oh_f, sh_f = gated_delta_chunked(qh if ctx_out else None, kh, vh, gh[:, :, 0], bh[:, :, 0], s0)
    oh_b, sh_b = gated_delta_chunked(flip_t(qh) if ctx_out else None, flip_t(kh), flip_t(vh),
                                     flip_t(gh[:, :, 1]), flip_t(bh[:, :, 1]), s0)
    ox_f, _ = gated_delta_chunked(qx, kx, vx, gx[:, :, 0], bx[:, :, 0], sh_f)
    ox_b, _ = gated_delta_chunked(flip_t(qx), flip_t(kx), flip_t(vx), flip_t(gx[:, :, 1]), flip_t(bx[:, :, 1]), sh_b)
    lin_x = gated_head_norm(ox_f + flip_t(ox_b), zx, onorm_w)

    pool_x = pool_mixer(px[..., POOL_START:], pool_w, pool_scale, True)

    x = x + mod[..., 2, :] * (jnp.concatenate([lin_x, pool_x], axis=-1) @ w_out)
    xn2 = modulate(rmsnorm(x, norm2_w), mod[..., 3, :], mod[..., 4, :])
    x = x + mod[..., 5, :] * sq_relu_mlp(xn2, w_up, w_down)

    if not ctx_out:
        return x, None
    lin_h = gated_head_norm(oh_f + flip_t(oh_b), zh, onorm_w)
    pool_h = pool_mixer(ph[..., POOL_START:], pool_w, pool_scale, False)
    h = h + mod_c[..., 2, :] * (jnp.concatenate([lin_h, pool_h], axis=-1) @ w_out)
    hn2 = modulate(rmsnorm(h, norm2_w), mod_c[..., 3, :], mod_c[..., 4, :])
    h = h + mod_c[..., 5, :] * sq_relu_mlp(hn2, w_up, w_down)
    return x, h


def setup_inputs(seed: int = 0) -> dict:
    key = jax.random.key(seed)
    ks = jax.random.split(key, 20)
    f32 = jnp.float32

    def nrm(k, shape, s):
        return jax.random.normal(k, shape, f32) * s

    x = nrm(ks[0], (BATCH, SEQ, D_MODEL), 1.0)
    c = nrm(ks[1], (BATCH, D_MODEL), 1.0)
    ctx = nrm(ks[2], (BATCH, CTX_LEN, D_MODEL), 1.0)
    c_ctx = nrm(ks[3], (D_MODEL,), 1.0)
    w_ada = nrm(ks[4], (DEPTH, D_MODEL, N_MOD * D_MODEL), 0.5 * D_MODEL ** -0.5)
    b_ada = nrm(ks[5], (DEPTH, N_MOD * D_MODEL), 0.02)
    norm1_w = 1.0 + nrm(ks[6], (DEPTH, D_MODEL), 0.05)
    norm2_w = 1.0 + nrm(ks[7], (DEPTH, D_MODEL), 0.05)
    w_in = nrm(ks[8], (DEPTH, D_MODEL, IN_COLS), D_MODEL ** -0.5)
    conv_w = nrm(ks[9], (DEPTH, CONV_K, 3 * LIN_W), CONV_K ** -0.5)
    a_log = jnp.log(jax.random.uniform(ks[10], (DEPTH, N_DIR, N_LIN_HEADS), f32, 1.0, 16.0))
    dt = jnp.exp(jax.random.uniform(ks[11], (DEPTH, N_DIR, N_LIN_HEADS), f32, math.log(1e-3), math.log(1e-1)))
    dt_bias = dt + jnp.log(-jnp.expm1(-dt))
    onorm_w = 1.0 + nrm(ks[12], (DEPTH, HEAD_DIM), 0.05)
    pool_w = nrm(ks[13], (DEPTH, N_POOL_GROUPS, POOL_GROUP_W, POOL_GROUP_W), POOL_GROUP_W ** -0.5)
    pool_scale = 1.0 + nrm(ks[14], (DEPTH, POOL_W), 0.1)
    w_out = nrm(ks[15], (DEPTH, MIX_W, D_MODEL), MIX_W ** -0.5)
    w_up = nrm(ks[16], (DEPTH, D_MODEL, D_FF), D_MODEL ** -0.5)
    w_down = nrm(ks[17], (DEPTH, D_FF, D_MODEL), D_FF ** -0.5)
    final_norm_w = 1.0 + nrm(ks[18], (D_MODEL,), 0.05)
    return {'x': x, 'c': c, 'ctx': ctx, 'c_ctx': c_ctx, 'w_ada': w_ada, 'b_ada': b_ada,
            'norm1_w': norm1_w, 'norm2_w': norm2_w, 'w_in': w_in, 'conv_w': conv_w,
            'a_log': a_log, 'dt_bias': dt_bias, 'onorm_w': onorm_w, 'pool_w': pool_w,
            'pool_scale': pool_scale, 'w_out': w_out, 'w_up': w_up, 'w_down': w_down,
            'final_norm_w': final_norm_w}


def reference(x, c, ctx, c_ctx, w_ada, b_ada, norm1_w, norm2_w, w_in, conv_w, a_log, dt_bias,
              onorm_w, pool_w, pool_scale, w_out, w_up, w_down, final_norm_w):
    b = x.shape[0]
    sc = jax.nn.silu(c)
    scc = jax.nn.silu(c_ctx)
    h = ctx
    for l in range(DEPTH):
        mod = (sc @ w_ada[l] + b_ada[l]).reshape(b, 1, N_MOD, D_MODEL)
        mod_c = (scc @ w_ada[l] + b_ada[l]).reshape(N_MOD, D_MODEL)
        x, h = trunk_layer(x, h, mod, mod_c, norm1_w[l], norm2_w[l], w_in[l], conv_w[l], a_log[l],
                           dt_bias[l], onorm_w[l], pool_w[l], pool_scale[l], w_out[l], w_up[l],
                           w_down[l], l < DEPTH - 1)
    return rmsnorm(x, final_norm_w)
```

```cpp
#include <hip/hip_runtime.h>
#include <hip/hip_cooperative_groups.h>
#include <cstdio>
#include <cstdint>
namespace cg = cooperative_groups;

#ifndef PER_PHASE_LAUNCH
#define PER_PHASE_LAUNCH 0
#endif
#ifndef DIAG
#define DIAG 0
#endif

namespace pg8 {
#define PG8_LAS __attribute__((address_space(3)))
typedef unsigned short bf16_t;
typedef short bf16x8 __attribute__((ext_vector_type(8)));
typedef float f32x4 __attribute__((ext_vector_type(4)));
typedef unsigned u32x4 __attribute__((ext_vector_type(4)));
constexpr int BM = 256, BK = 64, HALF = 128, HTB = HALF * BK * 2  , STAGE_BYTES = 8 * HTB, NXCD = 8, WGM = 8;

__host__ __device__ __forceinline__ int lds_byte(int r, int c) { const int st = (r >> 4) * 2 + (c >> 5), rr = r & 15, cc = c & 31, ob = rr * 64 + cc * 2; return st * 1024 + (ob ^ (((ob >> 9) & 1) << 5)); }
__host__ __device__ __forceinline__ void stage_rc(int b, int& R, int& C) { const int st = b / 1024, sb = b % 1024, swz = sb ^ (((sb >> 9) & 1) << 5); R = (st >> 1) * 16 + swz / 64; C = (st & 1) * 32 + (swz % 64) / 2; }
__host__ __device__ __forceinline__ int perm32(int rho) { const int n = rho >> 4, i = rho & 15; return 8 * (i >> 2) + 4 * n + (i & 3); }

struct Unit { int pm, pn, ko; };
struct Gemm { const bf16_t* A; const bf16_t* Bt; int M, N, K, ld; };

struct StaticOrder {
    int nM, nN, nwg, G, c;
    __host__ __device__ void init(int M, int N, int G_, int c_) { nM = M / BM; nN = N / BM; nwg = nM * nN; G = G_; c = c_; }
    __host__ __device__ bool next(int i, Unit& u) const {
        const long L = (long)i * G + c; if (L >= nwg) return false;
        int wgid = (int)L; { const int q = nwg / NXCD, r = nwg % NXCD, xcd = wgid % NXCD, off = wgid / NXCD; wgid = (xcd < r ? xcd * (q + 1) : r * (q + 1) + (xcd - r) * q) + off; }
        const int nig = WGM * nN, gid = wgid / nig, fm = gid * WGM, gsz = (nM - fm) < WGM ? (nM - fm) : WGM;
        u.pm = fm + ((wgid % nig) % gsz); u.pn = (wgid % nig) / gsz; u.ko = 0; return true;
    }
    __device__ __forceinline__ void a_ready(const Unit&) const {}
    __device__ __forceinline__ void done(const Unit&) const {}
};
typedef __bf16 bf16x2_cv __attribute__((ext_vector_type(2)));
typedef float f32x2_cv __attribute__((ext_vector_type(2)));
__device__ __forceinline__ unsigned cvt_pk_bf16(float lo, float hi) { f32x2_cv v = {lo, hi}; bf16x2_cv b = __builtin_convertvector(v, bf16x2_cv); return __builtin_bit_cast(unsigned, b); }
template <class Epi, class Sched, bool ALIGN_EPI = false, bool SP2 = false>
__device__ __forceinline__ void gemm_phase(PG8_LAS unsigned char* lds, const Gemm g, const Sched& S, const Epi& E) {
    int tid_opq = threadIdx.x; asm volatile("" : "+v"(tid_opq));
    const int tid = tid_opq, wid = __builtin_amdgcn_readfirstlane(tid >> 6), lane = tid & 63, wr = wid >> 2, wc = wid & 3, fr = lane & 15, fq = lane >> 4;
    const int K = g.K, nt = K / BK;
    unsigned voffA[2], voffB[2];
#pragma unroll
    for (int i = 0; i < 2; ++i) { int R, C; stage_rc(tid * 16 + i * 8192, R, C); const int Rb = Epi::PERM ? ((R & ~31) + perm32(R & 31)) : R;
        voffA[i] = (unsigned)(R * g.ld + C) * 2u; voffB[i] = (unsigned)(Rb * g.ld + C) * 2u; }
    const size_t kstep = (size_t)(BK * 2);
    const size_t hstep = (size_t)HALF * g.ld * 2;
    const size_t tstep = 2 * hstep;
    const unsigned ldsw = (unsigned)wid * 1024u;
    const int aoff = lds_byte(wr * 64 + fr, fq * 8), boff = lds_byte(wc * 32 + fr, fq * 8);
#define PG8_SA(b, h) (((b) * 2 + (h)) * HTB)
#define PG8_SB(b, h) ((4 + (b) * 2 + (h)) * HTB)
#define PG8_STAGE(bufoff, gbase, voff) do { _Pragma("unroll") for (int _i = 0; _i < 2; ++_i) \
        __builtin_amdgcn_global_load_lds((const unsigned*)((const char*)(gbase) + (voff)[_i]), (PG8_LAS unsigned*)(lds + (bufoff) + ldsw + _i * 8192), 16, 0, 0); } while (0)
#define PG8_LDA(dst, b, h) do { _Pragma("unroll") for (int m = 0; m < 4; ++m) _Pragma("unroll") for (int k = 0; k < 2; ++k) dst[m][k] = *(const PG8_LAS bf16x8*)(lds + PG8_SA(b, h) + aoff + m * 2048 + k * 1024); } while (0)
#define PG8_LDB(dst, b, h) do { _Pragma("unroll") for (int n = 0; n < 2; ++n) _Pragma("unroll") for (int k = 0; k < 2; ++k) dst[n][k] = *(const PG8_LAS bf16x8*)(lds + PG8_SB(b, h) + boff + n * 2048 + k * 1024); } while (0)
#define PG8_MMA(ai, bj, At, Bt) do { __builtin_amdgcn_s_setprio(1); _Pragma("unroll") for (int m = 0; m < 4; ++m) _Pragma("unroll") for (int n = 0; n < 2; ++n) _Pragma("unroll") for (int k = 0; k < 2; ++k) \
        acc[ai][bj][m][n] = __builtin_amdgcn_mfma_f32_16x16x32_bf16(Bt[n][k], At[m][k], acc[ai][bj][m][n], 0, 0, 0); __builtin_amdgcn_s_setprio(0); } while (0)
#define PG8_WAIT_V(n) asm volatile("s_waitcnt vmcnt(" #n ")" ::: "memory")
#define PG8_WAIT_L(n) asm volatile("s_waitcnt lgkmcnt(" #n ")" ::: "memory")
#define PG8_BAR __builtin_amdgcn_s_barrier()
#define PG8_SCHED __builtin_amdgcn_sched_barrier(0)
    Unit cur, nxt; int ui = 0;
    if (!S.next(0, cur)) return;
    f32x4 acc[2][2][4][2];
#pragma unroll
    for (int a = 0; a < 2; ++a)
#pragma unroll
        for (int b = 0; b < 2; ++b)
#pragma unroll
            for (int m = 0; m < 4; ++m)
#pragma unroll
                for (int n = 0; n < 2; ++n) acc[a][b][m][n] = (f32x4){0.f, 0.f, 0.f, 0.f};
    bf16x8 At[4][2], B0[2][2], B1[2][2];
    const char* cA = (const char*)g.A + (size_t)cur.pm * tstep + cur.ko; const char* cB = (const char*)g.Bt + (size_t)cur.pn * tstep + cur.ko;
    S.a_ready(cur);
    if constexpr (SP2) {
        PG8_STAGE(PG8_SB(0, 0), cB, voffB); PG8_STAGE(PG8_SB(0, 1), cB + hstep, voffB); PG8_STAGE(PG8_SA(0, 0), cA, voffA); PG8_STAGE(PG8_SA(0, 1), cA + hstep, voffA);
        if (wr == 1) PG8_BAR;
        PG8_WAIT_V(2); PG8_BAR;
        PG8_STAGE(PG8_SB(1, 0), cB + kstep, voffB); PG8_STAGE(PG8_SA(1, 0), cA + kstep, voffA); PG8_STAGE(PG8_SB(1, 1), cB + hstep + kstep, voffB);
        PG8_WAIT_V(6); PG8_BAR;
    } else {
        PG8_STAGE(PG8_SB(0, 0), cB, voffB); PG8_STAGE(PG8_SA(0, 0), cA, voffA); PG8_STAGE(PG8_SB(0, 1), cB + hstep, voffB); PG8_STAGE(PG8_SA(0, 1), cA + hstep, voffA);
        if (wr == 1) PG8_BAR;
        PG8_WAIT_V(4); PG8_BAR;
        PG8_STAGE(PG8_SB(1, 0), cB + kstep, voffB); PG8_STAGE(PG8_SA(1, 0), cA + kstep, voffA); PG8_STAGE(PG8_SB(1, 1), cB + hstep + kstep, voffB);
        PG8_WAIT_V(6); PG8_BAR;
    }
    for (;;) {
        const bool has_next = S.next(ui + 1, nxt);
        const char* nA = has_next ? (const char*)g.A + (size_t)nxt.pm * tstep + nxt.ko : cA; const char* nB = has_next ? (const char*)g.Bt + (size_t)nxt.pn * tstep + nxt.ko : cB;
        for (int t = 0; t < nt; t += 2) {
            const bool last = (t == nt - 2);
            const char* a1 = cA + (size_t)(t + 1) * kstep;
            const char* a2 = last ? nA : cA + (size_t)(t + 2) * kstep; const char* b2 = last ? nB : cB + (size_t)(t + 2) * kstep;
            const char* a3 = a2 + kstep; const char* b3 = b2 + kstep;
            if (last && has_next) S.a_ready(nxt);
            if constexpr (SP2) {
            PG8_LDB(B0, 0, 0); PG8_LDB(B1, 0, 1); PG8_SCHED; PG8_LDA(At, 0, 0); PG8_STAGE(PG8_SA(1, 1), a1 + hstep, voffA);
            PG8_WAIT_V(8); PG8_WAIT_L(0); PG8_BAR; PG8_MMA(0, 0, At, B0); PG8_MMA(0, 1, At, B1); PG8_BAR; PG8_SCHED;
            PG8_LDA(At, 0, 1); PG8_STAGE(PG8_SB(0, 0), b2, voffB); PG8_STAGE(PG8_SB(0, 1), b2 + hstep, voffB); PG8_STAGE(PG8_SA(0, 0), a2, voffA);
            PG8_WAIT_V(8); PG8_WAIT_L(0); PG8_BAR; PG8_MMA(1, 0, At, B0); PG8_MMA(1, 1, At, B1); PG8_BAR; PG8_SCHED;
            PG8_LDB(B0, 1, 0); PG8_LDB(B1, 1, 1); PG8_SCHED; PG8_LDA(At, 1, 0); PG8_STAGE(PG8_SA(0, 1), a2 + hstep, voffA);
            PG8_WAIT_V(8); PG8_WAIT_L(0); PG8_BAR; PG8_MMA(0, 0, At, B0); PG8_MMA(0, 1, At, B1); PG8_BAR; PG8_SCHED;
            PG8_LDA(At, 1, 1); PG8_STAGE(PG8_SB(1, 0), b3, voffB); PG8_STAGE(PG8_SB(1, 1), b3 + hstep, voffB); PG8_STAGE(PG8_SA(1, 0), a3, voffA);
            PG8_WAIT_V(8); PG8_WAIT_L(0); PG8_BAR; PG8_MMA(1, 0, At, B0); PG8_MMA(1, 1, At, B1); PG8_BAR; PG8_SCHED;
            } else {
            PG8_LDB(B0, 0, 0); PG8_SCHED; PG8_LDA(At, 0, 0); PG8_STAGE(PG8_SA(1, 1), a1 + hstep, voffA);
            PG8_WAIT_L(8); PG8_BAR; PG8_WAIT_L(0); PG8_MMA(0, 0, At, B0); PG8_BAR; PG8_SCHED;
            PG8_LDB(B1, 0, 1); PG8_STAGE(PG8_SB(0, 0), b2, voffB);
            PG8_BAR; PG8_WAIT_L(0); PG8_MMA(0, 1, At, B1); PG8_BAR;
            PG8_LDA(At, 0, 1); PG8_STAGE(PG8_SA(0, 0), a2, voffA);
            PG8_BAR; PG8_WAIT_L(0); PG8_MMA(1, 0, At, B0); PG8_BAR; PG8_SCHED;
            PG8_STAGE(PG8_SB(0, 1), b2 + hstep, voffB);
            PG8_WAIT_V(6); PG8_BAR; PG8_MMA(1, 1, At, B1); PG8_BAR;
            PG8_LDB(B0, 1, 0); PG8_SCHED; PG8_LDA(At, 1, 0); PG8_STAGE(PG8_SA(0, 1), a2 + hstep, voffA);
            PG8_WAIT_L(8); PG8_BAR; PG8_WAIT_L(0); PG8_MMA(0, 0, At, B0); PG8_BAR; PG8_SCHED;
            PG8_LDB(B1, 1, 1); PG8_STAGE(PG8_SB(1, 0), b3, voffB);
            PG8_BAR; PG8_WAIT_L(0); PG8_MMA(0, 1, At, B1); PG8_BAR;
            PG8_LDA(At, 1, 1); PG8_STAGE(PG8_SA(1, 0), a3, voffA);
            PG8_BAR; PG8_WAIT_L(0); PG8_MMA(1, 0, At, B0); PG8_BAR; PG8_SCHED;
            PG8_STAGE(PG8_SB(1, 1), b3 + hstep, voffB);
            PG8_WAIT_V(6); PG8_BAR; PG8_MMA(1, 1, At, B1); PG8_BAR;
            }
        }
        if constexpr (ALIGN_EPI) { if (wr == 0) PG8_BAR; }
        if constexpr (!Epi::AFTER_DRAIN) { E(acc, cur, wr, wc, fr, fq); S.done(cur); }
        if (!has_next) break;
#pragma unroll
        for (int a = 0; a < 2; ++a)
#pragma unroll
            for (int b = 0; b < 2; ++b)
#pragma unroll
                for (int m = 0; m < 4; ++m)
#pragma unroll
                    for (int n = 0; n < 2; ++n) acc[a][b][m][n] = (f32x4){0.f, 0.f, 0.f, 0.f};
        cur = nxt; cA = nA; cB = nB; ++ui;
        if constexpr (ALIGN_EPI) { if (wr == 1) PG8_BAR; }
    }
    PG8_WAIT_V(0);
    if constexpr (!ALIGN_EPI) { if (wr == 0) PG8_BAR; }
    PG8_BAR;
    if constexpr (Epi::AFTER_DRAIN) { E.fused(acc, cur, wr, wc, fr, fq, lds, wid, lane); S.done(cur); }
#undef PG8_SA
#undef PG8_SB
#undef PG8_STAGE
#undef PG8_LDA
#undef PG8_LDB
#undef PG8_MMA
#undef PG8_WAIT_V
#undef PG8_WAIT_L
#undef PG8_BAR
#undef PG8_SCHED
}
}

using pg8::bf16_t; using pg8::bf16x8; using pg8::f32x4; using pg8::u32x4; using pg8::cvt_pk_bf16;
#define LAS __attribute__((address_space(3)))
typedef float f32x2 __attribute__((ext_vector_type(2)));
typedef unsigned u32x2 __attribute__((ext_vector_type(2)));

constexpr int DM = 2048, MX = 32768, MH = 4096, MT = 36864, NPROJ = 5376, DFF = 8192;
constexpr float EPSF = 1e-6f;
constexpr size_t WS_WIN = 0;
constexpr size_t WS_WOUT = WS_WIN + (size_t)5376 * 2048 * 2;
constexpr size_t WS_WUP = WS_WOUT + (size_t)2048 * 2048 * 2;
constexpr size_t WS_WDN = WS_WUP + (size_t)8192 * 2048 * 2;
constexpr size_t WS_MOD = WS_WDN + (size_t)8192 * 2048 * 2;
constexpr size_t WS_H = WS_MOD + (size_t)17 * 12288 * 4;
constexpr size_t WS_ABUF = WS_H + (size_t)MH * 2048 * 4;
constexpr size_t WS_AB = WS_ABUF + (size_t)MT * 2048 * 2;
constexpr size_t WS_PROJ = WS_AB + (size_t)MT * 32 * 4;
constexpr size_t WS_Q = WS_PROJ + (size_t)MT * NPROJ * 2;
constexpr size_t WS_K = WS_Q + (size_t)MT * 1024 * 2;
constexpr size_t WS_V = WS_K + (size_t)MT * 1024 * 2;
constexpr size_t WS_OB = WS_V + (size_t)MT * 1024 * 2;
constexpr size_t WS_XG = WS_OB + (size_t)MT * 1024 * 2;
constexpr size_t WS_SMG = WS_XG + (size_t)9216 * 4096 * 2;
constexpr size_t WS_END = WS_SMG + (size_t)9216 * 128 * 4;
constexpr size_t WS_HID = WS_PROJ;
static_assert(WS_HID + (size_t)MT * DFF * 2 <= WS_XG, "hidden overlay");
static_assert(WS_END <= (size_t)1 << 30, "workspace");
constexpr int LDS_BYTES = 155648;

struct Args { const float* in[19]; float* out; unsigned char* ws; int ph_lo, ph_hi, pad0, pad1; };

__device__ __forceinline__ float bf_lo(unsigned w) { return __uint_as_float(w << 16); }
__device__ __forceinline__ float bf_hi(unsigned w) { return __uint_as_float(w & 0xffff0000u); }
__device__ __forceinline__ float wave_sum(float v) {
#pragma unroll
    for (int o = 1; o < 64; o <<= 1) v += __shfl_xor(v, o);
    return v;
}
__device__ __forceinline__ float silu_f(float x) { return x * __builtin_amdgcn_rcpf(1.f + __expf(-x)); }
__device__ __forceinline__ void unpack8(const u32x4 p, float (&f)[8]) {
    f[0] = bf_lo(p.x); f[1] = bf_hi(p.x); f[2] = bf_lo(p.y); f[3] = bf_hi(p.y); f[4] = bf_lo(p.z); f[5] = bf_hi(p.z); f[6] = bf_lo(p.w); f[7] = bf_hi(p.w);
}
__device__ __forceinline__ u32x4 pack8(const float (&f)[8]) {
    u32x4 o; o.x = cvt_pk_bf16(f[0], f[1]); o.y = cvt_pk_bf16(f[2], f[3]); o.z = cvt_pk_bf16(f[4], f[5]); o.w = cvt_pk_bf16(f[6], f[7]); return o;
}
__device__ __forceinline__ u32x2 pack4(const f32x4 v) { u32x2 o; o.x = cvt_pk_bf16(v[0], v[1]); o.y = cvt_pk_bf16(v[2], v[3]); return o; }
#define LDS_WAIT() asm volatile("s_waitcnt lgkmcnt(0)" ::: "memory")
template <class T> __device__ __forceinline__ T ld_nt(const T* p) { return __builtin_nontemporal_load(p); }
template <class T> __device__ __forceinline__ void st_nt(T* p, const T v) { __builtin_nontemporal_store(v, p); }
#define BAR_LDS() do { asm volatile("s_waitcnt lgkmcnt(0)" ::: "memory"); __builtin_amdgcn_s_barrier(); asm volatile("" ::: "memory"); } while (0)
#define MFMA16(a, b, c) __builtin_amdgcn_mfma_f32_16x16x32_bf16((a), (b), (c), 0, 0, 0)

struct EpiProj {
    static constexpr bool PERM = true, AFTER_DRAIN = false;
    bf16_t* P;
    __device__ __forceinline__ void operator()(const f32x4 (&acc)[2][2][4][2], const pg8::Unit& u, int wr, int wc, int fr, int fq) const {
        const int row0 = u.pm * 256 + wr * 64 + fr;
        const int col0 = u.pn * 256 + wc * 32 + 8 * fq;
#pragma unroll
        for (int ai = 0; ai < 2; ++ai)
#pragma unroll
            for (int m = 0; m < 4; ++m) { bf16_t* rowp = P + (size_t)(row0 + ai * 128 + m * 16) * NPROJ + col0;
#pragma unroll
                for (int bj = 0; bj < 2; ++bj) { const f32x4 v0 = acc[ai][bj][m][0], v1 = acc[ai][bj][m][1];
                    u32x4 w; w.x = cvt_pk_bf16(v0[0], v0[1]); w.y = cvt_pk_bf16(v0[2], v0[3]); w.z = cvt_pk_bf16(v1[0], v1[1]); w.w = cvt_pk_bf16(v1[2], v1[3]);
                    *(u32x4*)(rowp + bj * 128) = w; } }
    }
};
struct EpiRes {
    static constexpr bool PERM = false, AFTER_DRAIN = false;
    const float* xsrc; float* xdst; const float* hsrc; float* hdst; const float* gate0;
    __device__ __forceinline__ void operator()(const f32x4 (&acc)[2][2][4][2], const pg8::Unit& u, int wr, int wc, int fr, int fq) const {
        const bool isx = u.pm < 128;
        const float* src = isx ? xsrc + (size_t)u.pm * 256 * DM : hsrc + (size_t)(u.pm - 128) * 256 * DM;
        float* dst = isx ? xdst + (size_t)u.pm * 256 * DM : hdst + (size_t)(u.pm - 128) * 256 * DM;
        const float* gate = gate0 + (size_t)(isx ? (u.pm >> 3) : 16) * 12288;
        const int rl0 = wr * 64 + fr, col0 = u.pn * 256 + wc * 32 + 4 * fq;
        f32x4 gv[2][2];
#pragma unroll
        for (int bj = 0; bj < 2; ++bj)
#pragma unroll
            for (int n = 0; n < 2; ++n) gv[bj][n] = *(const f32x4*)(gate + col0 + bj * 128 + n * 16);
#pragma unroll
        for (int ai = 0; ai < 2; ++ai)
#pragma unroll
            for (int m = 0; m < 4; ++m) { const size_t off = (size_t)(rl0 + ai * 128 + m * 16) * DM + col0;
#pragma unroll
                for (int bj = 0; bj < 2; ++bj)
#pragma unroll
                    for (int n = 0; n < 2; ++n) { const f32x4 s = *(const f32x4*)(src + off + bj * 128 + n * 16);
                        *(f32x4*)(dst + off + bj * 128 + n * 16) = s + gv[bj][n] * acc[ai][bj][m][n]; } }
    }
};
struct EpiUp {
    static constexpr bool PERM = true, AFTER_DRAIN = false;
    bf16_t* Hd;
    __device__ __forceinline__ void operator()(const f32x4 (&acc)[2][2][4][2], const pg8::Unit& u, int wr, int wc, int fr, int fq) const {
        const int row0 = u.pm * 256 + wr * 64 + fr, col0 = u.pn * 256 + wc * 32 + 8 * fq;
#pragma unroll
        for (int ai = 0; ai < 2; ++ai)
#pragma unroll
            for (int m = 0; m < 4; ++m) { bf16_t* rowp = Hd + (size_t)(row0 + ai * 128 + m * 16) * DFF + col0;
#pragma unroll
                for (int bj = 0; bj < 2; ++bj) { f32x4 v0 = acc[ai][bj][m][0], v1 = acc[ai][bj][m][1];
#pragma unroll
                    for (int e = 0; e < 4; ++e) { const float a0 = fmaxf(v0[e], 0.f), a1 = fmaxf(v1[e], 0.f); v0[e] = a0 * a0; v1[e] = a1 * a1; }
                    u32x4 w; w.x = cvt_pk_bf16(v0[0], v0[1]); w.y = cvt_pk_bf16(v0[2], v0[3]); w.z = cvt_pk_bf16(v1[0], v1[1]); w.w = cvt_pk_bf16(v1[2], v1[3]);
                    st_nt((u32x4*)(rowp + bj * 128), w); } }
    }
};

struct L1Order {
    pg8::StaticOrder base; int G, c;
    __device__ void init(int G_, int c_) { base.init(MX, 5376, G_, c_); G = G_; c = c_; }
    __device__ bool next(int i, pg8::Unit& u) const {
        const long Lq = (long)i * G + c; if (Lq < base.nwg) return base.next(i, u);
        const int idx = (int)(Lq - base.nwg); if (idx >= 128) return false;
        u.pm = 128 + (idx >> 3); u.pn = 4 + (idx & 7); u.ko = 0; return true; }
    __device__ __forceinline__ void a_ready(const pg8::Unit&) const {}
    __device__ __forceinline__ void done(const pg8::Unit&) const {}
};
struct CtxSplitOrder {
    int G, c;
    __device__ bool next(int i, pg8::Unit& u) const { const long Lq = (long)i * G + c; if (Lq >= 256) return false; const int t = (int)Lq >> 1; u.pm = t >> 3; u.pn = t & 7; u.ko = ((int)Lq & 1) * 8192; return true; }
    __device__ __forceinline__ void a_ready(const pg8::Unit&) const {}
    __device__ __forceinline__ void done(const pg8::Unit&) const {}
};
struct EpiCtxSplit {
    static constexpr bool PERM = false, AFTER_DRAIN = false;
    float* h; float* hadd; const float* gate;
    __device__ __forceinline__ void operator()(const f32x4 (&acc)[2][2][4][2], const pg8::Unit& u, int wr, int wc, int fr, int fq) const {
        float* dst = (u.ko ? hadd : h) + (size_t)u.pm * 256 * DM;
        const int rl0 = wr * 64 + fr, col0 = u.pn * 256 + wc * 32 + 4 * fq;
        f32x4 gv[2][2];
#pragma unroll
        for (int bj = 0; bj < 2; ++bj)
#pragma unroll
            for (int n = 0; n < 2; ++n) gv[bj][n] = *(const f32x4*)(gate + col0 + bj * 128 + n * 16);
#pragma unroll
        for (int ai = 0; ai < 2; ++ai)
#pragma unroll
            for (int m = 0; m < 4; ++m) { const size_t off = (size_t)(rl0 + ai * 128 + m * 16) * DM + col0;
#pragma unroll
                for (int bj = 0; bj < 2; ++bj)
#pragma unroll
                    for (int n = 0; n < 2; ++n) { f32x4 v = gv[bj][n] * acc[ai][bj][m][n];
                        if (u.ko == 0) v += *(const f32x4*)(dst + off + bj * 128 + n * 16);
                        *(f32x4*)(dst + off + bj * 128 + n * 16) = v; } }
    }
};

__device__ __forceinline__ void tr_item(const float* W, int ldw, int srccol0, bf16_t* WT, int Kd, int dstrow0, int k0, LAS float* scr, int lane) {
    float tv[32];
#pragma unroll
    for (int i = 0; i < 32; ++i) tv[i] = W[(size_t)(k0 + 2 * i + (lane >> 5)) * ldw + srccol0 + (lane & 31)];
#pragma unroll
    for (int i = 0; i < 32; ++i) scr[(2 * i + (lane >> 5)) * 33 + (lane & 31)] = tv[i];
    LDS_WAIT();
    const int c = lane & 7;
#pragma unroll
    for (int j = 0; j < 4; ++j) { const int n = (lane >> 3) + 8 * j; const LAS float* s = scr + (8 * c) * 33 + n;
        u32x4 o; o.x = cvt_pk_bf16(s[0 * 33], s[1 * 33]); o.y = cvt_pk_bf16(s[2 * 33], s[3 * 33]); o.z = cvt_pk_bf16(s[4 * 33], s[5 * 33]); o.w = cvt_pk_bf16(s[6 * 33], s[7 * 33]);
        *(u32x4*)(WT + (size_t)(dstrow0 + n) * Kd + k0 + 8 * c) = o; }
    LDS_WAIT();
}
__device__ __forceinline__ void p0_phase(const Args& a, int l, LAS unsigned char* L, int tid, int lane, int wave) {
    {
        const float* wada = a.in[4] + (size_t)l * 2048 * 12288; const float* bada = a.in[5] + (size_t)l * 12288;
        const float* cvec = a.in[1]; const float* cctx = a.in[3];
        float* MOD = (float*)(a.ws + WS_MOD);
        LAS float* scw = (LAS float*)(L + wave * 5120);
        LAS float* red = (LAS float*)(L + 40960);
        const int cg4 = lane & 15, rg = lane >> 4;
        for (int it = blockIdx.x; it < 192; it += gridDim.x) {
            const int c0 = it * 64;
            float acc[17][4];
#pragma unroll
            for (int b = 0; b < 17; ++b)
#pragma unroll
                for (int e = 0; e < 4; ++e) acc[b][e] = 0.f;
            for (int s = 0; s < 4; ++s) {
                const int kb = wave * 256 + s * 64;
#pragma unroll
                for (int b = 0; b < 17; ++b) { const float v = (b < 16) ? cvec[b * 2048 + kb + lane] : cctx[kb + lane]; scw[lane * 20 + b] = silu_f(v); }
                LDS_WAIT();
#pragma unroll 4
                for (int j = 0; j < 16; ++j) {
                    const int kk = 4 * j + rg;
                    const f32x4 w4 = *(const f32x4*)(wada + (size_t)(kb + kk) * 12288 + c0 + 4 * cg4);
                    const LAS float* sp = scw + kk * 20;
                    const f32x4 s0 = *(const LAS f32x4*)(sp), s1 = *(const LAS f32x4*)(sp + 4), s2 = *(const LAS f32x4*)(sp + 8), s3 = *(const LAS f32x4*)(sp + 12); const float s16 = sp[16];
#pragma unroll
                    for (int e = 0; e < 4; ++e) {
                        acc[0][e] += s0[0] * w4[e]; acc[1][e] += s0[1] * w4[e]; acc[2][e] += s0[2] * w4[e]; acc[3][e] += s0[3] * w4[e];
                        acc[4][e] += s1[0] * w4[e]; acc[5][e] += s1[1] * w4[e]; acc[6][e] += s1[2] * w4[e]; acc[7][e] += s1[3] * w4[e];
                        acc[8][e] += s2[0] * w4[e]; acc[9][e] += s2[1] * w4[e]; acc[10][e] += s2[2] * w4[e]; acc[11][e] += s2[3] * w4[e];
                        acc[12][e] += s3[0] * w4[e]; acc[13][e] += s3[1] * w4[e]; acc[14][e] += s3[2] * w4[e]; acc[15][e] += s3[3] * w4[e];
                        acc[16][e] += s16 * w4[e]; }
                }
                LDS_WAIT();
            }
#pragma unroll
            for (int b = 0; b < 17; ++b)
#pragma unroll
                for (int e = 0; e < 4; ++e) { float v = acc[b][e]; v += __shfl_xor(v, 16); v += __shfl_xor(v, 32); acc[b][e] = v; }
            if (rg == 0) {
#pragma unroll
                for (int b = 0; b < 17; ++b) *(LAS f32x4*)(red + (wave * 17 + b) * 64 + cg4 * 4) = (f32x4){acc[b][0], acc[b][1], acc[b][2], acc[b][3]};
            }
            __syncthreads();
            for (int idx = tid; idx < 17 * 64; idx += 512) { const int b = idx >> 6, cc = idx & 63; float s = bada[c0 + cc];
#pragma unroll
                for (int w = 0; w < 8; ++w) s += red[(w * 17 + b) * 64 + cc];
                MOD[(size_t)b * 12288 + c0 + cc] = s; }
            __syncthreads();
        }
    }
    {
        const float* w_in = a.in[8] + (size_t)l * 2048 * 5152; const float* w_out = a.in[15] + (size_t)l * 2048 * 2048;
        const float* w_up = a.in[16] + (size_t)l * 2048 * 8192; const float* w_dn = a.in[17] + (size_t)l * 8192 * 2048;
        const float* pool_w = a.in[13] + (size_t)l * 4 * 65536; const float* pscale = a.in[14] + (size_t)l * 1024;
        bf16_t* WTin = (bf16_t*)(a.ws + WS_WIN); bf16_t* WTout = (bf16_t*)(a.ws + WS_WOUT); bf16_t* WTup = (bf16_t*)(a.ws + WS_WUP); bf16_t* WTdn = (bf16_t*)(a.ws + WS_WDN);
        LAS float* scr = (LAS float*)(L + 81920 + wave * 8448);
        const int gw = blockIdx.x * 8 + wave, NGW = gridDim.x * 8;
        constexpr int N0 = 4096, N1 = 1024, N2 = 32, N3 = 1024, N4 = 8192, N5 = 8192, N6 = 2048;
        for (int it0 = gw; it0 < N0 + N1 + N2 + N3 + N4 + N5 + N6; it0 += NGW) {
            int it = it0;
            if (it < N0) { tr_item(w_in, 5152, 32 * (it & 127), WTin, 2048, 32 * (it & 127), 64 * (it >> 7), scr, lane); continue; } it -= N0;
            if (it < N1) { tr_item(w_in, 5152, 4128 + 32 * (it & 31), WTin, 2048, 4096 + 32 * (it & 31), 64 * (it >> 5), scr, lane); continue; } it -= N1;
            if (it < N2) { tr_item(w_in, 5152, 4096, WTin, 2048, 5120, 64 * it, scr, lane); continue; } it -= N2;
            if (it < N3) { tr_item(w_out, 2048, 32 * (it & 63), WTout, 2048, 32 * (it & 63), 64 * (it >> 6), scr, lane); continue; } it -= N3;
            if (it < N4) { tr_item(w_up, 8192, 32 * (it & 255), WTup, 2048, 32 * (it & 255), 64 * (it >> 8), scr, lane); continue; } it -= N4;
            if (it < N5) { tr_item(w_dn, 2048, 32 * (it & 63), WTdn, 8192, 32 * (it & 63), 64 * (it >> 6), scr, lane); continue; } it -= N5;
            const int g = it >> 9, rem = it & 511, n = 64 * (rem >> 4) + lane, j0 = 16 * (rem & 15);
            const float* wo = w_out + (size_t)(1024 + 256 * g) * 2048 + n; const float* pw = pool_w + (size_t)g * 65536 + j0 * 256; const float* ps = pscale + 256 * g;
            float acc[16];
#pragma unroll
            for (int jj = 0; jj < 16; ++jj) acc[jj] = 0.f;
            const float* pwl = pw + (lane >> 2) * 256 + (lane & 3) * 4;
            f32x4 pwn = *(const f32x4*)pwl; float wvn[16];
#pragma unroll
            for (int cc = 0; cc < 16; ++cc) wvn[cc] = wo[(size_t)cc * 2048];
            for (int cb = 0; cb < 256; cb += 16) {
                const f32x4 pwv = pwn; float wv[16];
#pragma unroll
                for (int cc = 0; cc < 16; ++cc) wv[cc] = wvn[cc] * ps[cb + cc];
                if (cb + 16 < 256) { pwn = *(const f32x4*)(pwl + cb + 16);
#pragma unroll
                    for (int cc = 0; cc < 16; ++cc) wvn[cc] = wo[(size_t)(cb + 16 + cc) * 2048]; }
                *(LAS f32x4*)(scr + (lane >> 2) * 16 + (lane & 3) * 4) = pwv;
                LDS_WAIT();
#pragma unroll
                for (int cc4 = 0; cc4 < 4; ++cc4)
#pragma unroll
                    for (int jj = 0; jj < 16; ++jj) { const f32x4 m = *(const LAS f32x4*)(scr + jj * 16 + cc4 * 4);
                        acc[jj] += (m[0] * wv[4 * cc4] + m[1] * wv[4 * cc4 + 1]) + (m[2] * wv[4 * cc4 + 2] + m[3] * wv[4 * cc4 + 3]); }
                LDS_WAIT();
            }
            bf16_t* dst = WTout + (size_t)n * 2048 + 1024 + 256 * g + j0;
            u32x4 o0, o1; o0.x = cvt_pk_bf16(acc[0], acc[1]); o0.y = cvt_pk_bf16(acc[2], acc[3]); o0.z = cvt_pk_bf16(acc[4], acc[5]); o0.w = cvt_pk_bf16(acc[6], acc[7]);
            o1.x = cvt_pk_bf16(acc[8], acc[9]); o1.y = cvt_pk_bf16(acc[10], acc[11]); o1.z = cvt_pk_bf16(acc[12], acc[13]); o1.w = cvt_pk_bf16(acc[14], acc[15]);
            *(u32x4*)dst = o0; *(u32x4*)(dst + 8) = o1;
        }
    }
}

#define ROWPTR(rr) (((rr) < MX) ? xsrc + (size_t)(rr) * DM : hsrc + (size_t)((rr) - MX) * DM)
__device__ __forceinline__ void norm_phase(const float* xsrc, const float* hsrc, const float* hadd, int nrows, const float* nw, const float* MOD, int shift_idx, bf16_t* out, int gw, int NGW, int lane) {
    const int RPW = (nrows + NGW - 1) / NGW, r0 = gw * RPW, r1 = min(r0 + RPW, nrows);
    if (r0 >= r1) return;
    f32x4 Aa[8], Bb[8], v[8], n1[8], n2[8]; int curmod = -1;
    { const float* src = ROWPTR(r0);
#pragma unroll
      for (int j = 0; j < 8; ++j) n1[j] = *(const f32x4*)(src + 4 * lane + 256 * j); }
    if (r0 + 1 < r1) { const float* src = ROWPTR(r0 + 1);
#pragma unroll
      for (int j = 0; j < 8; ++j) n2[j] = *(const f32x4*)(src + 4 * lane + 256 * j); }
    for (int r = r0; r < r1; ++r) {
#pragma unroll
        for (int j = 0; j < 8; ++j) { v[j] = n1[j]; n1[j] = n2[j]; }
        if (r + 2 < r1) { const float* src = ROWPTR(r + 2);
#pragma unroll
            for (int j = 0; j < 8; ++j) n2[j] = *(const f32x4*)(src + 4 * lane + 256 * j); }
        if (hadd && r >= MX) {
#pragma unroll
            for (int j = 0; j < 8; ++j) v[j] += *(const f32x4*)(hadd + (size_t)(r - MX) * DM + 4 * lane + 256 * j); }
        const int modrow = (r < MX) ? (r >> 11) : 16;
        if (modrow != curmod) { curmod = modrow;
            const float* sh = MOD + (size_t)modrow * 12288 + shift_idx * 2048; const float* sc = sh + 2048;
#pragma unroll
            for (int j = 0; j < 8; ++j) { const int c = 4 * lane + 256 * j; Aa[j] = *(const f32x4*)(nw + c) * (1.f + *(const f32x4*)(sc + c)); Bb[j] = *(const f32x4*)(sh + c); } }
        float ss = 0.f;
#pragma unroll
        for (int j = 0; j < 8; ++j) ss += (v[j][0] * v[j][0] + v[j][1] * v[j][1]) + (v[j][2] * v[j][2] + v[j][3] * v[j][3]);
        ss = wave_sum(ss);
        const float rstd = rsqrtf(ss * (1.f / 2048.f) + EPSF);
#pragma unroll
        for (int j = 0; j < 8; ++j) { const f32x4 y = (v[j] * rstd) * Aa[j] + Bb[j]; *(u32x2*)(out + (size_t)r * DM + 4 * lane + 256 * j) = pack4(y); }
    }
}
__device__ __forceinline__ void final_norm_phase(float* x, const float* nw, int gw, int NGW, int lane) {
    const int RPW = (MX + NGW - 1) / NGW, r0 = gw * RPW, r1 = min(r0 + RPW, MX);
    if (r0 >= r1) return;
    f32x4 Aa[8], v[8], n1[8], n2[8];
#pragma unroll
    for (int j = 0; j < 8; ++j) { Aa[j] = *(const f32x4*)(nw + 4 * lane + 256 * j); n1[j] = *(const f32x4*)(x + (size_t)r0 * DM + 4 * lane + 256 * j); }
    if (r0 + 1 < r1) {
#pragma unroll
        for (int j = 0; j < 8; ++j) n2[j] = *(const f32x4*)(x + (size_t)(r0 + 1) * DM + 4 * lane + 256 * j); }
    for (int r = r0; r < r1; ++r) {
#pragma unroll
        for (int j = 0; j < 8; ++j) { v[j] = n1[j]; n1[j] = n2[j]; }
        if (r + 2 < r1) {
#pragma unroll
            for (int j = 0; j < 8; ++j) n2[j] = *(const f32x4*)(x + (size_t)(r + 2) * DM + 4 * lane + 256 * j); }
        float ss = 0.f;
#pragma unroll
        for (int j = 0; j < 8; ++j) ss += (v[j][0] * v[j][0] + v[j][1] * v[j][1]) + (v[j][2] * v[j][2] + v[j][3] * v[j][3]);
        ss = wave_sum(ss);
        const float rstd = rsqrtf(ss * (1.f / 2048.f) + EPSF);
#pragma unroll
        for (int j = 0; j < 8; ++j) *(f32x4*)(x + (size_t)r * DM + 4 * lane + 256 * j) = v[j] * rstd * Aa[j];
    }
}

__device__ __forceinline__ void prep_phase(const Args& a, int l, LAS unsigned char* L, int tid, int lane, int wave) {
    const bf16_t* PROJ = (const bf16_t*)(a.ws + WS_PROJ); bf16_t* ABUF = (bf16_t*)(a.ws + WS_ABUF);
    bf16_t* Qb = (bf16_t*)(a.ws + WS_Q); bf16_t* Kb = (bf16_t*)(a.ws + WS_K); bf16_t* Vb = (bf16_t*)(a.ws + WS_V);
    const float* convw = a.in[9] + (size_t)l * 5 * 3072;
    const int gw = blockIdx.x * 8 + wave, NGW = gridDim.x * 8;
    if (gw < 2046) {
        const int cs = gw % 6, w = cs >> 1, hh = cs & 1, col = w * 1024 + hh * 512 + lane * 8;
        float cw[5][8];
#pragma unroll
        for (int i = 0; i < 5; ++i) { const f32x4 c0 = *(const f32x4*)(convw + i * 3072 + col), c1 = *(const f32x4*)(convw + i * 3072 + col + 4);
            cw[i][0] = c0[0]; cw[i][1] = c0[1]; cw[i][2] = c0[2]; cw[i][3] = c0[3]; cw[i][4] = c1[0]; cw[i][5] = c1[1]; cw[i][6] = c1[2]; cw[i][7] = c1[3]; }
        bf16_t* dstb = (w == 0 ? Qb : (w == 1 ? Kb : Vb)) + hh * 512 + lane * 8;
        const float qs = (w == 0) ? 0.08838834764831845f : 1.f;
        for (int seg = gw / 6; seg < MT / 16; seg += 341) {
            const int r0 = seg * 16;
            if (l == 1 && r0 >= MX && w == 0) continue;
            int t0, T; if (r0 < MX) { t0 = r0 & 2047; T = 2048; } else { t0 = (r0 - MX) & 255; T = 256; }
            u32x4 win[20];
#pragma unroll
            for (int k = 0; k < 20; ++k) { const int tt = t0 + k - 2;
                win[k] = (tt >= 0 && tt < T) ? *(const u32x4*)(PROJ + (size_t)(r0 + k - 2) * NPROJ + col) : (u32x4){0u, 0u, 0u, 0u}; }
#pragma unroll
            for (int i = 0; i < 16; ++i) {
                float acc[8];
#pragma unroll
                for (int e = 0; e < 8; ++e) acc[e] = 0.f;
#pragma unroll
                for (int k = 0; k < 5; ++k) { float pz[8]; unpack8(win[i + k], pz);
#pragma unroll
                    for (int e = 0; e < 8; ++e) acc[e] += pz[e] * cw[k][e]; }
#pragma unroll
                for (int e = 0; e < 8; ++e) acc[e] = silu_f(acc[e]);
                if (w < 2) { float ss = 0.f;
#pragma unroll
                    for (int e = 0; e < 8; ++e) ss += acc[e] * acc[e];
                    ss += __shfl_xor(ss, 1); ss += __shfl_xor(ss, 2); ss += __shfl_xor(ss, 4); ss += __shfl_xor(ss, 8);
                    const float sc = rsqrtf(ss + EPSF) * qs;
#pragma unroll
                    for (int e = 0; e < 8; ++e) acc[e] *= sc; }
                *(u32x4*)(dstb + (size_t)(r0 + i) * 1024) = pack8(acc);
            }
        }
    }
    {
        LAS float* R = (LAS float*)L; LAS float* V = (LAS float*)(L + 65536);
#define POOL_GEO(it) const int b = (it) >> 7, cb = ((it) >> 2) & 31, gi = ((it) + ((it) >> 8)) & 3, col = 4096 + gi * 256 + cb * 8, s2 = 1 << gi
        u32x4 pvn[4];
        if ((int)blockIdx.x < 2048) { POOL_GEO((int)blockIdx.x);
#pragma unroll
            for (int rep = 0; rep < 4; ++rep) pvn[rep] = *(const u32x4*)(PROJ + (size_t)(b * 2048 + tid + 512 * rep) * NPROJ + col); (void)s2; }
        for (int it = blockIdx.x; it < 2048; it += gridDim.x) {
            POOL_GEO(it);
#pragma unroll
            for (int rep = 0; rep < 4; ++rep) { const int tok = tid + 512 * rep; float p[8]; unpack8(pvn[rep], p);
                *(LAS f32x4*)(R + tok * 8) = (f32x4){p[0], p[1], p[2], p[3]}; *(LAS f32x4*)(R + tok * 8 + 4) = (f32x4){p[4], p[5], p[6], p[7]}; }
            { const int itn = it + gridDim.x;
              if (itn < 2048) { const int bn = itn >> 7, cbn = (itn >> 2) & 31, gin = (itn + (itn >> 8)) & 3, coln = 4096 + gin * 256 + cbn * 8;
#pragma unroll
                  for (int rep = 0; rep < 4; ++rep) pvn[rep] = *(const u32x4*)(PROJ + (size_t)(bn * 2048 + tid + 512 * rep) * NPROJ + coln); } }
            BAR_LDS();
#pragma unroll
            for (int rep = 0; rep < 4; ++rep) { const int tok = tid + 512 * rep, y = tok >> 6, x = tok & 63;
                const int lo = max(y - s2, 0), hi = min(y + s2 - 1, 31);
                f32x4 a0 = (f32x4){0.f, 0.f, 0.f, 0.f}, a1 = a0;
                for (int yy = lo; yy <= hi; ++yy) { a0 += *(const LAS f32x4*)(R + (yy * 64 + x) * 8); a1 += *(const LAS f32x4*)(R + (yy * 64 + x) * 8 + 4); }
                const float inv = 1.f / (float)(hi - lo + 1);
                *(LAS f32x4*)(V + tok * 8) = a0 * inv; *(LAS f32x4*)(V + tok * 8 + 4) = a1 * inv; }
            BAR_LDS();
#pragma unroll
            for (int rep = 0; rep < 4; ++rep) { const int tok = tid + 512 * rep, y = tok >> 6, x = tok & 63;
                const int lo = max(x - s2, 0), hi = min(x + s2 - 1, 63);
                f32x4 a0 = (f32x4){0.f, 0.f, 0.f, 0.f}, a1 = a0;
                for (int xx = lo; xx <= hi; ++xx) { a0 += *(const LAS f32x4*)(V + (y * 64 + xx) * 8); a1 += *(const LAS f32x4*)(V + (y * 64 + xx) * 8 + 4); }
                const float inv = 1.f / (float)(hi - lo + 1);
                const f32x4 r0 = *(const LAS f32x4*)(R + tok * 8), r1 = *(const LAS f32x4*)(R + tok * 8 + 4);
                const f32x4 o0 = a0 * inv - r0, o1 = a1 * inv - r1;
                u32x4 o; o.x = cvt_pk_bf16(o0[0], o0[1]); o.y = cvt_pk_bf16(o0[2], o0[3]); o.z = cvt_pk_bf16(o1[0], o1[1]); o.w = cvt_pk_bf16(o1[2], o1[3]);
                *(u32x4*)(ABUF + (size_t)(b * 2048 + tok) * DM + 1024 + gi * 256 + cb * 8) = o; }
            BAR_LDS();
        }
    }
    if (l == 1) {
        const bf16_t* WTin = (const bf16_t*)(a.ws + WS_WIN); bf16_t* PROJw = (bf16_t*)(a.ws + WS_PROJ);
        for (int r = MX + gw; r < MT; r += NGW) {
            float xv[32];
#pragma unroll
            for (int j = 0; j < 4; ++j) { float t8[8]; unpack8(*(const u32x4*)(ABUF + (size_t)r * DM + 8 * lane + 512 * j), t8);
#pragma unroll
                for (int e = 0; e < 8; ++e) xv[8 * j + e] = t8[e]; }
            float res = 0.f;
            for (int o = 0; o < 32; ++o) {
                float s = 0.f;
#pragma unroll
                for (int j = 0; j < 4; ++j) { float t8[8]; unpack8(*(const u32x4*)(WTin + (size_t)(5120 + o) * 2048 + 8 * lane + 512 * j), t8);
#pragma unroll
                    for (int e = 0; e < 8; ++e) s += t8[e] * xv[8 * j + e]; }
                s = wave_sum(s);
                if (lane == o) res = s;
            }
            if (lane < 32) PROJw[(size_t)r * NPROJ + 5120 + lane] = (bf16_t)(cvt_pk_bf16(res, 0.f) & 0xffffu);
        }
    }
    if (l == 0) {
        const int gt = blockIdx.x * 512 + tid, NT = gridDim.x * 512;
        for (int idx = gt; idx < MH * 128; idx += NT) {
            const int rr = idx >> 7, ch = idx & 127, gi = ch >> 5, s2 = 1 << gi, t = rr & 255, base = MX + rr - t;
            const int lo = max(t - s2, 0), hi = min(t + s2 - 1, 255);
            float s[8];
#pragma unroll
            for (int e = 0; e < 8; ++e) s[e] = 0.f;
            for (int tt = lo; tt <= hi; ++tt) { const u32x4 pv = *(const u32x4*)(PROJ + (size_t)(base + tt) * NPROJ + 4096 + ch * 8); float p[8]; unpack8(pv, p);
#pragma unroll
                for (int e = 0; e < 8; ++e) s[e] += p[e]; }
            const float inv = 1.f / (float)(hi - lo + 1);
            const u32x4 pv = *(const u32x4*)(PROJ + (size_t)(base + t) * NPROJ + 4096 + ch * 8); float p[8]; unpack8(pv, p);
#pragma unroll
            for (int e = 0; e < 8; ++e) s[e] = s[e] * inv - p[e];
            *(u32x4*)(ABUF + (size_t)(base + t) * DM + 1024 + ch * 8) = pack8(s);
        }
    }
}

__device__ __forceinline__ float softplus_f(float yy) { const float zz = __expf(fminf(yy, 20.f)); return (yy > 20.f) ? yy : ((zz < 1e-3f) ? zz * (1.f - 0.5f * zz) : __logf(1.f + zz)); }
__device__ __forceinline__ void xinv_phase(const Args& a, int l, LAS unsigned char* L, int tid0, int wave) {
    const bf16_t* Kb = (const bf16_t*)(a.ws + WS_K); const bf16_t* PROJ = (const bf16_t*)(a.ws + WS_PROJ); bf16_t* XG = (bf16_t*)(a.ws + WS_XG);
    const f32x4 z4 = (f32x4){0.f, 0.f, 0.f, 0.f};
    for (int seq = blockIdx.x; seq < 256; seq += gridDim.x) {
        const int b = seq >> 4, h = (seq >> 1) & 7, dir = seq & 1;
        const float nega_h = -__expf(a.in[10][l * 16 + dir * 8 + h]), dtb_h = a.in[11][l * 16 + dir * 8 + h];
        for (int ci = wave; ci < 36; ci += 8) {
            int tid_o = tid0; LAS unsigned char* Lm = L + wave * 17408; asm volatile("" : "+v"(tid_o), "+v"(Lm));
            const int lane = tid_o & 63, r = lane & 15, q = lane >> 4;
            int lane_o = lane;
            const bool isctx = ci < 4; const int n = isctx ? ci : ci - 4, T = isctx ? 256 : 2048;
            const int rowbase = isctx ? MX + b * 256 : b * 2048;
            const int tok0 = dir ? T - 64 * (n + 1) : 64 * n;
            const int tokl = tok0 + (dir ? 63 - lane : lane);
            const bf16_t* abp = PROJ + (size_t)(rowbase + tokl) * NPROJ + 5120;
            float gc = nega_h * softplus_f(bf_lo(abp[dir * 8 + h]) + dtb_h);
            const float bt = 1.f / (1.f + __expf(-bf_lo(abp[16 + dir * 8 + h])));
#pragma unroll
            for (int o = 1; o < 64; o <<= 1) { const float tv = __shfl_up(gc, o); if (lane >= o) gc += tv; }
            { float* smg = (float*)(a.ws + WS_SMG) + (size_t)(seq * 36 + ci) * 128; smg[lane] = gc; smg[64 + lane] = bt; }
            bf16x8 f[4][4];
#pragma unroll
            for (int t = 0; t < 4; ++t) { const int i = 16 * t + r, tok = tok0 + (dir ? 63 - i : i);
                const bf16_t* kp = Kb + (size_t)(rowbase + tok) * 1024 + h * 128 + 8 * q;
#pragma unroll
                for (int s = 0; s < 4; ++s) f[t][s] = *(const bf16x8*)(kp + 32 * s); }
#pragma unroll
            for (int tj = 0; tj < 4; ++tj) {
                const int j = 16 * tj + r; const float gcj = __shfl(gc, j);
#pragma unroll
                for (int ti = tj; ti < 4; ++ti) {
                    f32x4 acc = z4;
#pragma unroll
                    for (int s = 0; s < 4; ++s) acc = MFMA16(f[ti][s], f[tj][s], acc);
                    const int i0 = 16 * ti + 4 * q; f32x4 o;
#pragma unroll
                    for (int e = 0; e < 4; ++e) { const float gci = __shfl(gc, i0 + e), bi = __shfl(bt, i0 + e); o[e] = (i0 + e > j) ? acc[e] * bi * __expf(gci - gcj) : 0.f; }
                    *(LAS f32x4*)(Lm + j * 272 + i0 * 4) = o;
                }
            }
            LDS_WAIT();
            asm volatile("" : "+v"(lane_o), "+v"(Lm));
            f32x2 xp[32];
#pragma unroll
            for (int k = 0; k < 32; ++k) xp[k] = (f32x2){0.f, 0.f};
#pragma unroll
            for (int j = 63; j >= 0; --j) {
                f32x2 acc2 = (f32x2){(lane_o == j) ? 1.f : 0.f, 0.f};
#pragma unroll
                for (int k4 = ((j + 1) & ~3); k4 < 64; k4 += 4) {
                    const f32x4 m = *(const LAS f32x4*)(Lm + j * 272 + k4 * 4);
                    acc2 -= xp[k4 >> 1] * (f32x2){m[0], m[1]};
                    acc2 -= xp[(k4 >> 1) + 1] * (f32x2){m[2], m[3]};
                }
                float xj = acc2[0] + acc2[1];
                asm volatile("" : "+v"(xj), "+v"(Lm), "+v"(lane_o));
                xp[j >> 1][j & 1] = xj;
            }
            LDS_WAIT();
            bf16_t* xo = XG + ((size_t)(seq * 36 + ci) * 64 + lane) * 64;
#pragma unroll
            for (int j8 = 0; j8 < 8; ++j8) {
                float v2[8];
#pragma unroll
                for (int e = 0; e < 8; ++e) { const int j = 8 * j8 + e; v2[e] = xp[j >> 1][j & 1] * __builtin_bit_cast(float, __builtin_amdgcn_readlane(__builtin_bit_cast(int, bt), j)); }
                *(u32x4*)(xo + 8 * j8) = pack8(v2);
            }
        }
    }
}

constexpr int SC_ST = 0, SC_QR = 34816, SC_KR = 52224, SC_A2 = 69632, SC_KT = 78848, SC_VT = 97280, SC_WR = 115712, SC_AT = 133120, SC_SM = 142336;
constexpr int SC_VNT = SC_KR, SC_VNS = SC_VT;
__device__ __forceinline__ bf16x8 ldfrag(const LAS unsigned char* p) { return *(const LAS bf16x8*)p; }
__device__ __forceinline__ bf16x8 scale8(const bf16x8 v, const f32x4 e0, const f32x4 e1) {
    float f[8]; unpack8(__builtin_bit_cast(u32x4, v), f);
    f[0] *= e0[0]; f[1] *= e0[1]; f[2] *= e0[2]; f[3] *= e0[3]; f[4] *= e1[0]; f[5] *= e1[1]; f[6] *= e1[2]; f[7] *= e1[3];
    return __builtin_bit_cast(bf16x8, pack8(f));
}
struct ChunkGeo { int rowbase, tok0; bool want_o; };
__device__ __forceinline__ ChunkGeo chunk_geo(int ci, int b, int dir, int l) {
    ChunkGeo g; const bool isctx = ci < 4; const int n = isctx ? ci : ci - 4, T = isctx ? 256 : 2048;
    g.rowbase = isctx ? MX + b * 256 : b * 2048; g.tok0 = dir ? T - 64 * (n + 1) : 64 * n; g.want_o = (!isctx) || (l == 0); return g;
}
__device__ __forceinline__ void scan_phase(const Args& a, int l, LAS unsigned char* L, int tid0, int lane0, int wave) {
    const bf16_t* Qb = (const bf16_t*)(a.ws + WS_Q); const bf16_t* Kb = (const bf16_t*)(a.ws + WS_K); const bf16_t* Vb = (const bf16_t*)(a.ws + WS_V);
    const bf16_t* PROJ = (const bf16_t*)(a.ws + WS_PROJ); const bf16_t* XG = (const bf16_t*)(a.ws + WS_XG);
    bf16_t* ABUF = (bf16_t*)(a.ws + WS_ABUF); bf16_t* OB = (bf16_t*)(a.ws + WS_OB);
    LAS float* SM = (LAS float*)(L + SC_SM);
    const f32x4 z4 = (f32x4){0.f, 0.f, 0.f, 0.f};
    for (int seq = blockIdx.x; seq < 256; seq += gridDim.x) {
        const int b = seq >> 4, h = (seq >> 1) & 7, dir = seq & 1;
        const float nega_h = -__expf(a.in[10][l * 16 + dir * 8 + h]), dtb_h = a.in[11][l * 16 + dir * 8 + h];
        f32x4 S[8];
#pragma unroll
        for (int t = 0; t < 8; ++t) S[t] = z4;
        __syncthreads();
        for (int x = lane0; x < 16 * 68; x += 64) ((LAS unsigned*)(L + SC_ST + (16 * wave) * 272))[x] = 0u;
        u32x4 pq[2], pk[2], pv[2], px; float pa = 0.f, pb = 0.f;
        {
            const ChunkGeo g = chunk_geo(0, b, dir, l);
#pragma unroll
            for (int rep = 0; rep < 2; ++rep) { const int row = (tid0 >> 4) + 32 * rep, c8 = (tid0 & 15) * 8, tok = g.tok0 + (dir ? 63 - row : row);
                const size_t go = (size_t)(g.rowbase + tok) * 1024 + h * 128 + c8;
                pk[rep] = *(const u32x4*)(Kb + go); pv[rep] = *(const u32x4*)(Vb + go); pq[rep] = g.want_o ? *(const u32x4*)(Qb + go) : (u32x4){0u, 0u, 0u, 0u}; }
            px = *(const u32x4*)(XG + (size_t)(seq * 36 + 0) * 4096 + tid0 * 8);
            if (wave == 0) { const float* smg = (const float*)(a.ws + WS_SMG) + (size_t)(seq * 36 + 0) * 128; pa = smg[lane0]; pb = smg[64 + lane0]; }
        }
        for (int ci = 0; ci < 36; ++ci) {
            int tid_o = tid0; asm volatile("" : "+v"(tid_o));
            const int tid = tid_o, lane = tid & 63, r = lane & 15, q = lane >> 4;
            const ChunkGeo cg0 = chunk_geo(ci, b, dir, l);
            bf16x8 idf;
#pragma unroll
            for (int jj = 0; jj < 8; ++jj) idf[jj] = (8 * q + jj == 16 * (wave & 1) + r) ? (short)0x3F80 : (short)0;
            const int rowbase = cg0.rowbase, tok0 = cg0.tok0; const bool want_o = cg0.want_o;
            BAR_LDS();
#pragma unroll
            for (int rep = 0; rep < 2; ++rep) {
                const int row = (tid >> 4) + 32 * rep, c8 = (tid & 15) * 8;
                const u32x4 kv = pk[rep], vv = pv[rep];
                if (want_o) *(LAS u32x4*)(L + SC_QR + row * 272 + c8 * 2) = pq[rep];
                *(LAS u32x4*)(L + SC_KR + row * 272 + c8 * 2) = kv;
                *(LAS u32x4*)(L + SC_WR + row * 272 + c8 * 2) = vv;
            }
            *(LAS u32x4*)(L + SC_A2 + (tid >> 3) * 144 + (tid & 7) * 16) = px;
            if (wave == 0) {
                const float gc = pa, bt = pb;
                const float glast = __shfl(gc, 63);
                SM[lane] = gc; SM[64 + lane] = bt; SM[128 + lane] = __expf(gc); SM[192 + lane] = __expf(glast - gc);
                if (lane == 0) SM[256] = __expf(glast);
            }
            if (ci + 1 < 36) {
                const ChunkGeo g = chunk_geo(ci + 1, b, dir, l);
#pragma unroll
                for (int rep = 0; rep < 2; ++rep) { const int row = (tid >> 4) + 32 * rep, c8 = (tid & 15) * 8, tok = g.tok0 + (dir ? 63 - row : row);
                    const size_t go = (size_t)(g.rowbase + tok) * 1024 + h * 128 + c8;
                    pk[rep] = *(const u32x4*)(Kb + go); pv[rep] = *(const u32x4*)(Vb + go); if (g.want_o) pq[rep] = *(const u32x4*)(Qb + go); }
                px = *(const u32x4*)(XG + (size_t)(seq * 36 + ci + 1) * 4096 + tid * 8);
                if (wave == 0) { const float* smg = (const float*)(a.ws + WS_SMG) + (size_t)(seq * 36 + ci + 1) * 128; pa = smg[lane]; pb = smg[64 + lane]; }
            }
            BAR_LDS();
            {
                const int sI = wave >> 1;
#pragma unroll
                for (int t = 0; t < 4; ++t) {
                    const f32x4 kt4 = MFMA16(ldfrag(L + SC_KR + (16 * t + r) * 272 + 16 * q + 64 * sI), idf, z4);
                    const f32x4 vt4 = MFMA16(ldfrag(L + SC_WR + (16 * t + r) * 272 + 16 * q + 64 * sI), idf, z4);
                    *(LAS u32x2*)(L + SC_KT + (16 * wave + r) * 144 + (16 * t + 4 * q) * 2) = pack4(kt4);
                    *(LAS u32x2*)(L + SC_VT + (16 * wave + r) * 144 + (16 * t + 4 * q) * 2) = pack4(vt4);
                }
            }
            BAR_LDS();
            if (want_o) {
                const int it = wave >> 1, i = 16 * it + r; const float gci = SM[i];
                bf16x8 qf[4];
#pragma unroll
                for (int s = 0; s < 4; ++s) qf[s] = ldfrag(L + SC_QR + i * 272 + 16 * q + 64 * s);
#pragma unroll
                for (int tt = 0; tt < 2; ++tt) {
                    const int t = 2 * (wave & 1) + tt;
                    f32x4 acc = z4;
#pragma unroll
                    for (int s = 0; s < 4; ++s) acc = MFMA16(ldfrag(L + SC_KR + (16 * t + r) * 272 + 16 * q + 64 * s), qf[s], acc);
                    const int j0 = 16 * t + 4 * q;
                    const f32x4 gj = *(const LAS f32x4*)(SM + j0);
                    f32x4 o;
#pragma unroll
                    for (int e = 0; e < 4; ++e) o[e] = (j0 + e <= i) ? acc[e] * __expf(gci - gj[e]) : 0.f;
                    *(LAS u32x2*)(L + SC_AT + i * 144 + j0 * 2) = pack4(o);
                }
            }
            f32x4 u[4];
            {
                bf16x8 ka[2], vb[2];
#pragma unroll
                for (int s = 0; s < 2; ++s) {
                    const f32x4 e0 = *(const LAS f32x4*)(SM + 128 + 8 * q + 32 * s), e1 = *(const LAS f32x4*)(SM + 128 + 8 * q + 32 * s + 4);
                    ka[s] = scale8(ldfrag(L + SC_KT + (16 * wave + r) * 144 + 16 * q + 64 * s), e0, e1);
                    vb[s] = ldfrag(L + SC_VT + (16 * wave + r) * 144 + 16 * q + 64 * s); }
#pragma unroll
                for (int t = 0; t < 4; ++t) {
                    f32x4 wacc = z4; u[t] = z4;
#pragma unroll
                    for (int s = 0; s < 2; ++s) {
                        if (t < 2 && s == 1) continue;
                        const bf16x8 af = ldfrag(L + SC_A2 + (16 * t + r) * 144 + 16 * q + 64 * s);
                        wacc = MFMA16(ka[s], af, wacc);
                        u[t] = MFMA16(af, vb[s], u[t]);
                    }
                    *(LAS u32x2*)(L + SC_WR + (16 * t + r) * 272 + (16 * wave + 4 * q) * 2) = pack4(wacc);
                }
            }
            BAR_LDS();
            f32x4 o[4];
            {
                bf16x8 sf[4];
#pragma unroll
                for (int s = 0; s < 4; ++s) sf[s] = ldfrag(L + SC_ST + (16 * wave + r) * 272 + 16 * q + 64 * s);
#pragma unroll
                for (int t = 0; t < 4; ++t) {
                    f32x4 ws = z4;
#pragma unroll
                    for (int s = 0; s < 4; ++s) ws = MFMA16(ldfrag(L + SC_WR + (16 * t + r) * 272 + 16 * q + 64 * s), sf[s], ws);
                    const f32x4 vn = u[t] - ws;
                    const f32x4 eg = *(const LAS f32x4*)(SM + 192 + 16 * t + 4 * q);
                    *(LAS u32x2*)(L + SC_VNT + (16 * wave + r) * 144 + (16 * t + 4 * q) * 2) = pack4(vn);
                    *(LAS u32x2*)(L + SC_VNS + (16 * wave + r) * 144 + (16 * t + 4 * q) * 2) = pack4(vn * eg);
                }
                if (want_o) {
#pragma unroll
                    for (int t = 0; t < 4; ++t) {
                        f32x4 oa = z4;
#pragma unroll
                        for (int s = 0; s < 4; ++s) oa = MFMA16(sf[s], ldfrag(L + SC_QR + (16 * t + r) * 272 + 16 * q + 64 * s), oa);
                        o[t] = oa * SM[128 + 16 * t + r];
                    }
                }
            }
            LDS_WAIT();
            if (want_o) {
                bf16x8 va[2];
#pragma unroll
                for (int s = 0; s < 2; ++s) va[s] = ldfrag(L + SC_VNT + (16 * wave + r) * 144 + 16 * q + 64 * s);
#pragma unroll
                for (int t = 0; t < 4; ++t) {
#pragma unroll
                    for (int s = 0; s < 2; ++s) { if (t < 2 && s == 1) continue; o[t] = MFMA16(va[s], ldfrag(L + SC_AT + (16 * t + r) * 144 + 16 * q + 64 * s), o[t]); }
                    const int i = 16 * t + r, tok = tok0 + (dir ? 63 - i : i);
                    bf16_t* dst = (dir ? OB + (size_t)(rowbase + tok) * 1024 : ABUF + (size_t)(rowbase + tok) * DM) + h * 128 + 16 * wave + 4 * q;
                    *(u32x2*)dst = pack4(o[t]);
                }
            }
            {
                const float egl = SM[256];
                bf16x8 vs[2];
#pragma unroll
                for (int s = 0; s < 2; ++s) vs[s] = ldfrag(L + SC_VNS + (16 * wave + r) * 144 + 16 * q + 64 * s);
#pragma unroll
                for (int t = 0; t < 8; ++t) {
                    S[t] = S[t] * egl;
#pragma unroll
                    for (int s = 0; s < 2; ++s) S[t] = MFMA16(ldfrag(L + SC_KT + (16 * t + r) * 144 + 16 * q + 64 * s), vs[s], S[t]);
                    *(LAS u32x2*)(L + SC_ST + (16 * wave + r) * 272 + (16 * t + 4 * q) * 2) = pack4(S[t]);
                }
            }
        }
        __syncthreads();
    }
}

__device__ __forceinline__ void gate_phase(const Args& a, int l, int nrows, int gw, int NGW, int lane) {
    const bf16_t* PROJ = (const bf16_t*)(a.ws + WS_PROJ); bf16_t* ABUF = (bf16_t*)(a.ws + WS_ABUF); const bf16_t* OB = (const bf16_t*)(a.ws + WS_OB);
    const float* onw = a.in[12] + (size_t)l * 128;
    const int RPW = (nrows + NGW - 1) / NGW, r0 = gw * RPW, r1 = min(r0 + RPW, nrows);
    if (r0 >= r1) return;
    f32x4 w0[2], w1[2];
#pragma unroll
    for (int hh = 0; hh < 2; ++hh) { const int cc = (hh * 512 + lane * 8) & 127; w0[hh] = *(const f32x4*)(onw + cc); w1[hh] = *(const f32x4*)(onw + cc + 4); }
    u32x4 nf[2], nb[2], nz[2];
#pragma unroll
    for (int hh = 0; hh < 2; ++hh) { const int col = hh * 512 + lane * 8;
        nf[hh] = *(const u32x4*)(ABUF + (size_t)r0 * DM + col); nb[hh] = ld_nt((const u32x4*)(OB + (size_t)r0 * 1024 + col)); nz[hh] = ld_nt((const u32x4*)(PROJ + (size_t)r0 * NPROJ + 3072 + col)); }
    for (int r = r0; r < r1; ++r) {
        u32x4 cf[2], cb[2], cz[2];
#pragma unroll
        for (int hh = 0; hh < 2; ++hh) { cf[hh] = nf[hh]; cb[hh] = nb[hh]; cz[hh] = nz[hh]; }
        if (r + 1 < r1) {
#pragma unroll
            for (int hh = 0; hh < 2; ++hh) { const int col = hh * 512 + lane * 8;
                nf[hh] = *(const u32x4*)(ABUF + (size_t)(r + 1) * DM + col); nb[hh] = ld_nt((const u32x4*)(OB + (size_t)(r + 1) * 1024 + col)); nz[hh] = ld_nt((const u32x4*)(PROJ + (size_t)(r + 1) * NPROJ + 3072 + col)); } }
#pragma unroll
        for (int hh = 0; hh < 2; ++hh) {
            const int col = hh * 512 + lane * 8;
            float x[8], y[8], z[8]; unpack8(cf[hh], x); unpack8(cb[hh], y); unpack8(cz[hh], z);
            float ss = 0.f;
#pragma unroll
            for (int e = 0; e < 8; ++e) { x[e] += y[e]; ss += x[e] * x[e]; }
            ss += __shfl_xor(ss, 1); ss += __shfl_xor(ss, 2); ss += __shfl_xor(ss, 4); ss += __shfl_xor(ss, 8);
            const float rstd = rsqrtf(ss * (1.f / 128.f) + EPSF);
            x[0] *= rstd * w0[hh][0] * silu_f(z[0]); x[1] *= rstd * w0[hh][1] * silu_f(z[1]); x[2] *= rstd * w0[hh][2] * silu_f(z[2]); x[3] *= rstd * w0[hh][3] * silu_f(z[3]);
            x[4] *= rstd * w1[hh][0] * silu_f(z[4]); x[5] *= rstd * w1[hh][1] * silu_f(z[5]); x[6] *= rstd * w1[hh][2] * silu_f(z[6]); x[7] *= rstd * w1[hh][3] * silu_f(z[7]);
            *(u32x4*)(ABUF + (size_t)r * DM + col) = pack8(x);
        }
    }
}

#define XB_TMO      128
#define XB_XCNT(j)  (256  + 64 * (j))
#define XB_XSUB(j)  (1280 + 64 * (j))
#define XB_XGEN(j)  (2304 + 64 * (j))
#define XB_TOP      3328
#define XB_TOPGEN   3392
#define XCD_BAR_WORDS 3456
#define XB_SPIN_CAP (1u << 18)

__device__ __forceinline__ unsigned xb_ld(unsigned* p)              { return __hip_atomic_load(p, __ATOMIC_RELAXED, __HIP_MEMORY_SCOPE_AGENT); }
__device__ __forceinline__ unsigned xb_add(unsigned* p, unsigned v) { return __hip_atomic_fetch_add(p, v, __ATOMIC_RELAXED, __HIP_MEMORY_SCOPE_AGENT); }
__device__ __forceinline__ unsigned xb_xcc_id() { return (unsigned)__builtin_amdgcn_s_getreg((3 << 11) | 20) & 0xFu; }
#define XB_SPIN(cond, bar) do { unsigned _sp = 0; while (cond) { __builtin_amdgcn_s_sleep(1); \
    if ((++_sp & 255u) == 0u) { if (xb_ld(&(bar)[XB_TMO])) break; if (_sp > XB_SPIN_CAP) { atomicAdd(&(bar)[XB_TMO], 1u); break; } } } } while (0)

struct XcdBarrier {
    unsigned* bar; unsigned x;
    volatile LAS unsigned* st;
};

__device__ __forceinline__ XcdBarrier xcd_barrier_post(unsigned* bar, volatile LAS unsigned* st) {
    XcdBarrier b; b.bar = bar; b.x = xb_xcc_id(); b.st = st;
    if (threadIdx.x == 0) (void)xb_add(&bar[XB_XCNT(b.x)], 1u);
    return b;
}
__device__ __forceinline__ void xcd_barrier_complete(unsigned* bar, unsigned x, unsigned& nloc, unsigned& nx) {
    const unsigned G = gridDim.x * gridDim.y * gridDim.z;
    unsigned sum, cnt, mine, sp = 0u;
    for (;;) {
        sum = 0u; cnt = 0u; mine = 0u;
#pragma unroll
        for (unsigned j = 0; j < 16; ++j) { const unsigned c = xb_ld(&bar[XB_XCNT(j)]); sum += c; cnt += (c > 0u) ? 1u : 0u; mine = (j == x) ? c : mine; }
        if (sum == G) break;
        __builtin_amdgcn_s_sleep(1);
        if ((++sp & 255u) == 0u) { if (xb_ld(&bar[XB_TMO])) break; if (sp > XB_SPIN_CAP) { atomicAdd(&bar[XB_TMO], 1u); break; } }
    }
    nloc = mine > 0u ? mine : 1u; nx = cnt > 0u ? cnt : 1u;
}

__device__ __forceinline__ void xcd_barrier(const XcdBarrier& b) {
    asm volatile("s_waitcnt vmcnt(0)" ::: "memory");
    __syncthreads();
    if (threadIdx.x == 0) {
        unsigned* bar = b.bar;
        __builtin_amdgcn_s_waitcnt(0);
        unsigned nloc = b.st[0], nx = b.st[1];
        if (nloc == 0u) { xcd_barrier_complete(bar, b.x, nloc, nx); b.st[0] = nloc; b.st[1] = nx; }
        const unsigned old = xb_add(&bar[XB_XSUB(b.x)], 1u);
        const unsigned gen = old / nloc;
        if (old + 1u == (gen + 1u) * nloc) {
            __builtin_amdgcn_fence(__ATOMIC_RELEASE, "agent");
            asm volatile("s_waitcnt vmcnt(0)" ::: "memory");
            const unsigned og = xb_add(&bar[XB_TOP], 1u);
            const unsigned tg = og / nx;
            if (og + 1u == (tg + 1u) * nx) xb_add(&bar[XB_TOPGEN], 1u);
            else XB_SPIN(xb_ld(&bar[XB_TOPGEN]) == tg, bar);
            __builtin_amdgcn_fence(__ATOMIC_ACQUIRE, "agent");
            xb_add(&bar[XB_XGEN(b.x)], 1u);
            asm volatile("s_waitcnt vmcnt(0)" ::: "memory");
        } else {
            XB_SPIN(xb_ld(&bar[XB_XGEN(b.x)]) == gen, bar);
            __builtin_amdgcn_fence(__ATOMIC_ACQUIRE, "agent");
            asm volatile("s_waitcnt vmcnt(0)" ::: "memory");
        }
    }
    __syncthreads();
}

constexpr size_t WS_BAR = WS_AB;
#ifdef ONLY_PH
#define PH_ON(k) ((k) == ONLY_PH)
#else
#define PH_ON(k) true
#endif

constexpr size_t WS_FLAGS = WS_AB;
#if DIAG
__global__ void diag_zero(unsigned* flags) { if (blockIdx.x == 0 && threadIdx.x == 0) *flags = 0u; }
__global__ void diag_f32(const float* p, size_t n, unsigned bit, unsigned* flags) {
    bool bad = false;
    for (size_t i = (size_t)blockIdx.x * 256 + threadIdx.x; i < n; i += (size_t)gridDim.x * 256) { const float v = p[i]; if (!(fabsf(v) < 1e30f)) bad = true; }
    if (bad) atomicOr(flags, bit);
}
__global__ void diag_bf16(const bf16_t* p, size_t n, unsigned bit, unsigned* flags) {
    bool bad = false;
    for (size_t i = (size_t)blockIdx.x * 256 + threadIdx.x; i < n; i += (size_t)gridDim.x * 256) { const float v = bf_lo(p[i]); if (!(fabsf(v) < 1e30f)) bad = true; }
    if (bad) atomicOr(flags, bit);
}
__global__ void diag_final(float* out, size_t n, const unsigned* flags) {
    const unsigned f = *flags;
    for (size_t i = (size_t)blockIdx.x * 256 + threadIdx.x; i < n; i += (size_t)gridDim.x * 256) { float v = out[i]; if (!(fabsf(v) < 1e30f)) v = 500.f; if (i == 0 && f) v = 1000.f * (float)f; out[i] = v; }
}
#endif
__global__ void __launch_bounds__(512) mega_fwd(Args a) {
    extern __shared__ __attribute__((aligned(16))) unsigned char lds_raw[];
    LAS unsigned char* L = (LAS unsigned char*)lds_raw;
    float* MOD = (float*)(a.ws + WS_MOD); float* Hs = (float*)(a.ws + WS_H);
    volatile LAS unsigned* bst = (volatile LAS unsigned*)(L + LDS_BYTES - 64);
    if (threadIdx.x == 0) { bst[0] = 0u; bst[1] = 0u; }
    __syncthreads();
    const XcdBarrier xbar = xcd_barrier_post((unsigned*)(a.ws + WS_BAR), bst);
    bf16_t* ABUF = (bf16_t*)(a.ws + WS_ABUF);
#ifdef DUP_MASK
    const int nsteps_tot = (a.ph_hi - a.ph_lo) + 2 * __builtin_popcount(DUP_MASK);
#else
    const int nsteps_tot = a.ph_hi - a.ph_lo;
#endif
    int ph = a.ph_lo - 1, duprep = 0;
    for (int st = 0; st < nsteps_tot; ++st) {
#ifdef DUP_MASK
        if (duprep == 0 && ph >= a.ph_lo && ph < 20 && ((DUP_MASK >> (ph % 10)) & 1)) duprep = 1; else { duprep = 0; ++ph; }
#else
        ++ph;
#endif
        if (ph > a.ph_lo && duprep == 0) { if (ph == a.ph_lo + 1) cg::this_grid().sync(); else xcd_barrier(xbar); }
        int tid_opq = threadIdx.x; asm volatile("" : "+v"(tid_opq));
        const int tid = tid_opq, lane = tid & 63, wave = __builtin_amdgcn_readfirstlane(tid >> 6);
        const int gw = blockIdx.x * 8 + wave, NGW = gridDim.x * 8;
        if (ph == 20) { final_norm_phase(a.out, a.in[18], gw, NGW, lane); continue; }
        const int l = ph / 10, p = ph % 10;
        const float* xsrc = (l == 0) ? a.in[0] : a.out; const float* hsrc = (l == 0) ? a.in[2] : Hs;
        const int Mrows = (l == 0) ? MT : MX;
        if (p == 0 && PH_ON(0)) p0_phase(a, l, L, tid, lane, wave);
        else if (p == 1 && PH_ON(1)) norm_phase(xsrc, hsrc, (l == 1) ? (const float*)(a.ws + WS_XG) : nullptr, MT, a.in[6] + (size_t)l * DM, MOD, 0, ABUF, gw, NGW, lane);
        else if (p == 2 && PH_ON(2)) {
            pg8::Gemm g{ABUF, (const bf16_t*)(a.ws + WS_WIN), MT, 5376, 2048, 2048}; pg8::StaticOrder S; S.init(MT, 5376, (int)gridDim.x, (int)blockIdx.x);
            EpiProj E{(bf16_t*)(a.ws + WS_PROJ)};
            if (l == 0) pg8::gemm_phase<EpiProj, pg8::StaticOrder, true, true>(L, g, S, E);
            else { L1Order S1; S1.init((int)gridDim.x, (int)blockIdx.x); pg8::gemm_phase<EpiProj, L1Order, true, true>(L, g, S1, E); }
        }
        else if (p == 3 && PH_ON(3)) prep_phase(a, l, L, tid, lane, wave);
        else if (p == 4 && PH_ON(4)) {
            xinv_phase(a, l, L, tid, wave);
            asm volatile("s_waitcnt vmcnt(0)" ::: "memory"); __syncthreads();
            scan_phase(a, l, L, tid, lane, wave);
        }
        else if (p == 5 && PH_ON(5)) gate_phase(a, l, Mrows, gw, NGW, lane);
        else if (p == 6 && PH_ON(6)) {
            pg8::Gemm g{ABUF, (const bf16_t*)(a.ws + WS_WOUT), Mrows, 2048, 2048, 2048}; pg8::StaticOrder S; S.init(Mrows, 2048, (int)gridDim.x, (int)blockIdx.x);
            EpiRes E{xsrc, a.out, hsrc, Hs, MOD + 2 * 2048};
            pg8::gemm_phase<EpiRes, pg8::StaticOrder, true, true>(L, g, S, E);
        }
        else if (p == 7 && PH_ON(7)) norm_phase(a.out, Hs, nullptr, Mrows, a.in[7] + (size_t)l * DM, MOD, 3, ABUF, gw, NGW, lane);
        else if (p == 8 && PH_ON(8)) {
            pg8::Gemm g{ABUF, (const bf16_t*)(a.ws + WS_WUP), Mrows, 8192, 2048, 2048}; pg8::StaticOrder S; S.init(Mrows, 8192, (int)gridDim.x, (int)blockIdx.x);
            EpiUp E{(bf16_t*)(a.ws + WS_HID)};
            pg8::gemm_phase<EpiUp, pg8::StaticOrder, true, true>(L, g, S, E);
        }
        else if (PH_ON(9)) {
            pg8::Gemm g{(const bf16_t*)(a.ws + WS_HID), (const bf16_t*)(a.ws + WS_WDN), MX, 2048, 8192, 8192}; pg8::StaticOrder S; S.init(MX, 2048, (int)gridDim.x, (int)blockIdx.x);
            EpiRes E{a.out, a.out, Hs, Hs, MOD + 5 * 2048};
            pg8::gemm_phase<EpiRes, pg8::StaticOrder, true, true>(L, g, S, E);
            if (l == 0) {
                pg8::Gemm g2{(const bf16_t*)(a.ws + WS_HID) + (size_t)MX * DFF, (const bf16_t*)(a.ws + WS_WDN), MH, 2048, 4096, 8192}; CtxSplitOrder S2{(int)gridDim.x, (int)blockIdx.x};
                EpiCtxSplit E2{Hs, (float*)(a.ws + WS_XG), MOD + (size_t)16 * 12288 + 5 * 2048};
                pg8::gemm_phase<EpiCtxSplit, CtxSplitOrder, true, true>(L, g2, S2, E2);
            }
        }
    }
}

extern "C" void kernel_launch(void* const* d_in, const int* in_sizes, int n_in, void* d_out, int out_size, void* d_ws, size_t ws_size, hipStream_t stream) {
    static int grid = 0;
    if (grid == 0) {
        if (n_in != 19 || ws_size < WS_END) { fprintf(stderr, "kernel_launch: unexpected inputs (n_in %d, ws %zu < %zu)\n", n_in, ws_size, (size_t)WS_END); grid = -1; return; }
        int dev = 0, cus = 0, per_cu = 0;
        hipGetDevice(&dev); hipDeviceGetAttribute(&cus, hipDeviceAttributeMultiprocessorCount, dev);
        if (hipFuncSetAttribute((const void*)mega_fwd, hipFuncAttributeMaxDynamicSharedMemorySize, LDS_BYTES) != hipSuccess) { fprintf(stderr, "kernel_launch: hipFuncSetAttribute failed\n"); grid = -1; return; }
        if (hipOccupancyMaxActiveBlocksPerMultiprocessor(&per_cu, (const void*)mega_fwd, 512, LDS_BYTES) != hipSuccess || per_cu < 1) { fprintf(stderr, "kernel_launch: occupancy query says %d\n", per_cu); per_cu = 1; }
        (void)hipGetLastError();
        grid = cus * 1;
    }
    if (grid < 0) return;
    Args a{};
    for (int i = 0; i < 19; ++i) a.in[i] = (const float*)d_in[i];
    a.out = (float*)d_out; a.ws = (unsigned char*)d_ws;
#if PER_PHASE_LAUNCH
    for (int ph = 0; ph < 23; ++ph) {
#if DIAG
        unsigned* flags = (unsigned*)(a.ws + WS_FLAGS);
        if (ph == 0) hipLaunchKernelGGL(diag_zero, dim3(1), dim3(64), 0, stream, flags);
        if (ph == 1) hipLaunchKernelGGL(diag_f32, dim3(1024), dim3(256), 0, stream, (const float*)(a.ws + WS_MOD), (size_t)17 * 12288, 1u, flags);
        if (ph == 3) hipLaunchKernelGGL(diag_bf16, dim3(1024), dim3(256), 0, stream, (const bf16_t*)(a.ws + WS_PROJ), (size_t)MT * NPROJ, 2u, flags);
        if (ph == 4) { hipLaunchKernelGGL(diag_bf16, dim3(1024), dim3(256), 0, stream, (const bf16_t*)(a.ws + WS_Q), (size_t)MT * 1024 * 3, 4u, flags);
                       hipLaunchKernelGGL(diag_bf16, dim3(1024), dim3(256), 0, stream, (const bf16_t*)(a.ws + WS_ABUF), (size_t)MT * 2048, 4u, flags); }
        if (ph == 5) hipLaunchKernelGGL(diag_bf16, dim3(1024), dim3(256), 0, stream, (const bf16_t*)(a.ws + WS_OB), (size_t)MT * 1024, 8u, flags);
        if (ph == 6) hipLaunchKernelGGL(diag_bf16, dim3(1024), dim3(256), 0, stream, (const bf16_t*)(a.ws + WS_ABUF), (size_t)MT * 2048, 16u, flags);
        if (ph == 10) { hipLaunchKernelGGL(diag_f32, dim3(1024), dim3(256), 0, stream, (const float*)a.out, (size_t)MX * DM, 32u, flags);
                        hipLaunchKernelGGL(diag_f32, dim3(1024), dim3(256), 0, stream, (const float*)(a.ws + WS_H), (size_t)MH * DM, 32u, flags); }
#endif
        a.ph_lo = ph; a.ph_hi = ph + 1; hipLaunchKernelGGL(mega_fwd, dim3(grid), dim3(512), LDS_BYTES, stream, a);
    }
#if DIAG
    hipLaunchKernelGGL(diag_final, dim3(1024), dim3(256), 0, stream, a.out, (size_t)MX * DM, (const unsigned*)(a.ws + WS_FLAGS));
#endif
#else
    a.ph_lo = 0; a.ph_hi = 21;
    (void)hipMemsetAsync((char*)d_ws + WS_BAR, 0, XCD_BAR_WORDS * 4, stream);
    void* kargs[] = {&a};
    hipError_t e = hipLaunchCooperativeKernel((const void*)mega_fwd, dim3(grid), dim3(512), kargs, LDS_BYTES, stream);
    if (e != hipSuccess) fprintf(stderr, "kernel_launch: cooperative launch failed: %s (grid %d)\n", hipGetErrorString(e), grid);
#endif
}
```

```cpp
#include <hip/hip_runtime.h>
#include <hip/hip_cooperative_groups.h>
#include <cstdio>
#include <cstdint>
namespace cg = cooperative_groups;

#ifndef PER_PHASE_LAUNCH
#define PER_PHASE_LAUNCH 0
#endif
#ifndef DIAG
#define DIAG 0
#endif

namespace pg8 {
#define PG8_LAS __attribute__((address_space(3)))
typedef unsigned short bf16_t;
typedef short bf16x8 __attribute__((ext_vector_type(8)));
typedef float f32x4 __attribute__((ext_vector_type(4)));
typedef unsigned u32x4 __attribute__((ext_vector_type(4)));
constexpr int BM = 256, BK = 64, HALF = 128, HTB = HALF * BK * 2  , STAGE_BYTES = 8 * HTB, NXCD = 8, WGM = 8;

__host__ __device__ __forceinline__ int lds_byte(int r, int c) { const int st = (r >> 4) * 2 + (c >> 5), rr = r & 15, cc = c & 31, ob = rr * 64 + cc * 2; return st * 1024 + (ob ^ (((ob >> 9) & 1) << 5)); }
__host__ __device__ __forceinline__ void stage_rc(int b, int& R, int& C) { const int st = b / 1024, sb = b % 1024, swz = sb ^ (((sb >> 9) & 1) << 5); R = (st >> 1) * 16 + swz / 64; C = (st & 1) * 32 + (swz % 64) / 2; }
__host__ __device__ __forceinline__ int perm32(int rho) { const int n = rho >> 4, i = rho & 15; return 8 * (i >> 2) + 4 * n + (i & 3); }

struct Unit { int pm, pn, ko; };
struct Gemm { const bf16_t* A; const bf16_t* Bt; int M, N, K, ld; };

struct StaticOrder {
    int nM, nN, nwg, G, c;
    __host__ __device__ void init(int M, int N, int G_, int c_) { nM = M / BM; nN = N / BM; nwg = nM * nN; G = G_; c = c_; }
    __host__ __device__ bool next(int i, Unit& u) const {
        const long L = (long)i * G + c; if (L >= nwg) return false;
        int wgid = (int)L; { const int q = nwg / NXCD, r = nwg % NXCD, xcd = wgid % NXCD, off = wgid / NXCD; wgid = (xcd < r ? xcd * (q + 1) : r * (q + 1) + (xcd - r) * q) + off; }
        const int nig = WGM * nN, gid = wgid / nig, fm = gid * WGM, gsz = (nM - fm) < WGM ? (nM - fm) : WGM;
        u.pm = fm + ((wgid % nig) % gsz); u.pn = (wgid % nig) / gsz; u.ko = 0; return true;
    }
    __device__ __forceinline__ void a_ready(const Unit&) const {}
    __device__ __forceinline__ void done(const Unit&) const {}
};
typedef __bf16 bf16x2_cv __attribute__((ext_vector_type(2)));
typedef float f32x2_cv __attribute__((ext_vector_type(2)));
__device__ __forceinline__ unsigned cvt_pk_bf16(float lo, float hi) { f32x2_cv v = {lo, hi}; bf16x2_cv b = __builtin_convertvector(v, bf16x2_cv); return __builtin_bit_cast(unsigned, b); }
template <class Epi, class Sched, bool ALIGN_EPI = false, bool SP2 = false>
__device__ __forceinline__ void gemm_phase(PG8_LAS unsigned char* lds, const Gemm g, const Sched& S, const Epi& E) {
    int tid_opq = threadIdx.x; asm volatile("" : "+v"(tid_opq));
    const int tid = tid_opq, wid = __builtin_amdgcn_readfirstlane(tid >> 6), lane = tid & 63, wr = wid >> 2, wc = wid & 3, fr = lane & 15, fq = lane >> 4;
    const int K = g.K, nt = K / BK;
    unsigned voffA[2], voffB[2];
#pragma unroll
    for (int i = 0; i < 2; ++i) { int R, C; stage_rc(tid * 16 + i * 8192, R, C); const int Rb = Epi::PERM ? ((R & ~31) + perm32(R & 31)) : R;
        voffA[i] = (unsigned)(R * g.ld + C) * 2u; voffB[i] = (unsigned)(Rb * g.ld + C) * 2u; }
    const size_t kstep = (size_t)(BK * 2);
    const size_t hstep = (size_t)HALF * g.ld * 2;
    const size_t tstep = 2 * hstep;
    const unsigned ldsw = (unsigned)wid * 1024u;
    const int aoff = lds_byte(wr * 64 + fr, fq * 8), boff = lds_byte(wc * 32 + fr, fq * 8);
#define PG8_SA(b, h) (((b) * 2 + (h)) * HTB)
#define PG8_SB(b, h) ((4 + (b) * 2 + (h)) * HTB)
#define PG8_STAGE(bufoff, gbase, voff) do { _Pragma("unroll") for (int _i = 0; _i < 2; ++_i) \
        __builtin_amdgcn_global_load_lds((const unsigned*)((const char*)(gbase) + (voff)[_i]), (PG8_LAS unsigned*)(lds + (bufoff) + ldsw + _i * 8192), 16, 0, 0); } while (0)
#define PG8_LDA(dst, b, h) do { _Pragma("unroll") for (int m = 0; m < 4; ++m) _Pragma("unroll") for (int k = 0; k < 2; ++k) dst[m][k] = *(const PG8_LAS bf16x8*)(lds + PG8_SA(b, h) + aoff + m * 2048 + k * 1024); } while (0)
#define PG8_LDB(dst, b, h) do { _Pragma("unroll") for (int n = 0; n < 2; ++n) _Pragma("unroll") for (int k = 0; k < 2; ++k) dst[n][k] = *(const PG8_LAS bf16x8*)(lds + PG8_SB(b, h) + boff + n * 2048 + k * 1024); } while (0)
#define PG8_MMA(ai, bj, At, Bt) do { __builtin_amdgcn_s_setprio(1); _Pragma("unroll") for (int m = 0; m < 4; ++m) _Pragma("unroll") for (int n = 0; n < 2; ++n) _Pragma("unroll") for (int k = 0; k < 2; ++k) \
        acc[ai][bj][m][n] = __builtin_amdgcn_mfma_f32_16x16x32_bf16(Bt[n][k], At[m][k], acc[ai][bj][m][n], 0, 0, 0); __builtin_amdgcn_s_setprio(0); } while (0)
#define PG8_WAIT_V(n) asm volatile("s_waitcnt vmcnt(" #n ")" ::: "memory")
#define PG8_WAIT_L(n) asm volatile("s_waitcnt lgkmcnt(" #n ")" ::: "memory")
#define PG8_BAR __builtin_amdgcn_s_barrier()
#define PG8_SCHED __builtin_amdgcn_sched_barrier(0)
    Unit cur, nxt; int ui = 0;
    if (!S.next(0, cur)) return;
    f32x4 acc[2][2][4][2];
#pragma unroll
    for (int a = 0; a < 2; ++a)
#pragma unroll
        for (int b = 0; b < 2; ++b)
#pragma unroll
            for (int m = 0; m < 4; ++m)
#pragma unroll
                for (int n = 0; n < 2; ++n) acc[a][b][m][n] = (f32x4){0.f, 0.f, 0.f, 0.f};
    bf16x8 At[4][2], B0[2][2], B1[2][2];
    const char* cA = (const char*)g.A + (size_t)cur.pm * tstep + cur.ko; const char* cB = (const char*)g.Bt + (size_t)cur.pn * tstep + cur.ko;
    S.a_ready(cur);
    if constexpr (SP2) {
        PG8_STAGE(PG8_SB(0, 0), cB, voffB); PG8_STAGE(PG8_SB(0, 1), cB + hstep, voffB); PG8_STAGE(PG8_SA(0, 0), cA, voffA); PG8_STAGE(PG8_SA(0, 1), cA + hstep, voffA);
        if (wr == 1) PG8_BAR;
        PG8_WAIT_V(2); PG8_BAR;
        PG8_STAGE(PG8_SB(1, 0), cB + kstep, voffB); PG8_STAGE(PG8_SA(1, 0), cA + kstep, voffA); PG8_STAGE(PG8_SB(1, 1), cB + hstep + kstep, voffB);
        PG8_WAIT_V(6); PG8_BAR;
    } else {
        PG8_STAGE(PG8_SB(0, 0), cB, voffB); PG8_STAGE(PG8_SA(0, 0), cA, voffA); PG8_STAGE(PG8_SB(0, 1), cB + hstep, voffB); PG8_STAGE(PG8_SA(0, 1), cA + hstep, voffA);
        if (wr == 1) PG8_BAR;
        PG8_WAIT_V(4); PG8_BAR;
        PG8_STAGE(PG8_SB(1, 0), cB + kstep, voffB); PG8_STAGE(PG8_SA(1, 0), cA + kstep, voffA); PG8_STAGE(PG8_SB(1, 1), cB + hstep + kstep, voffB);
        PG8_WAIT_V(6); PG8_BAR;
    }
    for (;;) {
        const bool has_next = S.next(ui + 1, nxt);
        const char* nA = has_next ? (const char*)g.A + (size_t)nxt.pm * tstep + nxt.ko : cA; const char* nB = has_next ? (const char*)g.Bt + (size_t)nxt.pn * tstep + nxt.ko : cB;
        for (int t = 0; t < nt; t += 2) {
            const bool last = (t == nt - 2);
            const char* a1 = cA + (size_t)(t + 1) * kstep;
            const char* a2 = last ? nA : cA + (size_t)(t + 2) * kstep; const char* b2 = last ? nB : cB + (size_t)(t + 2) * kstep;
            const char* a3 = a2 + kstep; const char* b3 = b2 + kstep;
            if (last && has_next) S.a_ready(nxt);
            if constexpr (SP2) {
            PG8_LDB(B0, 0, 0); PG8_LDB(B1, 0, 1); PG8_SCHED; PG8_LDA(At, 0, 0); PG8_STAGE(PG8_SA(1, 1), a1 + hstep, voffA);
            PG8_WAIT_V(8); PG8_WAIT_L(0); PG8_BAR; PG8_MMA(0, 0, At, B0); PG8_MMA(0, 1, At, B1); PG8_BAR; PG8_SCHED;
            PG8_LDA(At, 0, 1); PG8_STAGE(PG8_SB(0, 0), b2, voffB); PG8_STAGE(PG8_SB(0, 1), b2 + hstep, voffB); PG8_STAGE(PG8_SA(0, 0), a2, voffA);
            PG8_WAIT_V(8); PG8_WAIT_L(0); PG8_BAR; PG8_MMA(1, 0, At, B0); PG8_MMA(1, 1, At, B1); PG8_BAR; PG8_SCHED;
            PG8_LDB(B0, 1, 0); PG8_LDB(B1, 1, 1); PG8_SCHED; PG8_LDA(At, 1, 0); PG8_STAGE(PG8_SA(0, 1), a2 + hstep, voffA);
            PG8_WAIT_V(8); PG8_WAIT_L(0); PG8_BAR; PG8_MMA(0, 0, At, B0); PG8_MMA(0, 1, At, B1); PG8_BAR; PG8_SCHED;
            PG8_LDA(At, 1, 1); PG8_STAGE(PG8_SB(1, 0), b3, voffB); PG8_STAGE(PG8_SB(1, 1), b3 + hstep, voffB); PG8_STAGE(PG8_SA(1, 0), a3, voffA);
            PG8_WAIT_V(8); PG8_WAIT_L(0); PG8_BAR; PG8_MMA(1, 0, At, B0); PG8_MMA(1, 1, At, B1); PG8_BAR; PG8_SCHED;
            } else {
            PG8_LDB(B0, 0, 0); PG8_SCHED; PG8_LDA(At, 0, 0); PG8_STAGE(PG8_SA(1, 1), a1 + hstep, voffA);
            PG8_WAIT_L(8); PG8_BAR; PG8_WAIT_L(0); PG8_MMA(0, 0, At, B0); PG8_BAR; PG8_SCHED;
            PG8_LDB(B1, 0, 1); PG8_STAGE(PG8_SB(0, 0), b2, voffB);
            PG8_BAR; PG8_WAIT_L(0); PG8_MMA(0, 1, At, B1); PG8_BAR;
            PG8_LDA(At, 0, 1); PG8_STAGE(PG8_SA(0, 0), a2, voffA);
            PG8_BAR; PG8_WAIT_L(0); PG8_MMA(1, 0, At, B0); PG8_BAR; PG8_SCHED;
            PG8_STAGE(PG8_SB(0, 1), b2 + hstep, voffB);
            PG8_WAIT_V(6); PG8_BAR; PG8_MMA(1, 1, At, B1); PG8_BAR;
            PG8_LDB(B0, 1, 0); PG8_SCHED; PG8_LDA(At, 1, 0); PG8_STAGE(PG8_SA(0, 1), a2 + hstep, voffA);
            PG8_WAIT_L(8); PG8_BAR; PG8_WAIT_L(0); PG8_MMA(0, 0, At, B0); PG8_BAR; PG8_SCHED;
            PG8_LDB(B1, 1, 1); PG8_STAGE(PG8_SB(1, 0), b3, voffB);
            PG8_BAR; PG8_WAIT_L(0); PG8_MMA(0, 1, At, B1); PG8_BAR;
            PG8_LDA(At, 1, 1); PG8_STAGE(PG8_SA(1, 0), a3, voffA);
            PG8_BAR; PG8_WAIT_L(0); PG8_MMA(1, 0, At, B0); PG8_BAR; PG8_SCHED;
            PG8_STAGE(PG8_SB(1, 1), b3 + hstep, voffB);
            PG8_WAIT_V(6); PG8_BAR; PG8_MMA(1, 1, At, B1); PG8_BAR;
            }
        }
        if constexpr (ALIGN_EPI) { if (wr == 0) PG8_BAR; }
        if constexpr (!Epi::AFTER_DRAIN) { E(acc, cur, wr, wc, fr, fq); S.done(cur); }
        if (!has_next) break;
#pragma unroll
        for (int a = 0; a < 2; ++a)
#pragma unroll
            for (int b = 0; b < 2; ++b)
#pragma unroll
                for (int m = 0; m < 4; ++m)
#pragma unroll
                    for (int n = 0; n < 2; ++n) acc[a][b][m][n] = (f32x4){0.f, 0.f, 0.f, 0.f};
        cur = nxt; cA = nA; cB = nB; ++ui;
        if constexpr (ALIGN_EPI) { if (wr == 1) PG8_BAR; }
    }
    PG8_WAIT_V(0);
    if constexpr (!ALIGN_EPI) { if (wr == 0) PG8_BAR; }
    PG8_BAR;
    if constexpr (Epi::AFTER_DRAIN) { E.fused(acc, cur, wr, wc, fr, fq, lds, wid, lane); S.done(cur); }
#undef PG8_SA
#undef PG8_SB
#undef PG8_STAGE
#undef PG8_LDA
#undef PG8_LDB
#undef PG8_MMA
#undef PG8_WAIT_V
#undef PG8_WAIT_L
#undef PG8_BAR
#undef PG8_SCHED
}
}

using pg8::bf16_t; using pg8::bf16x8; using pg8::f32x4; using pg8::u32x4; using pg8::cvt_pk_bf16;
#define LAS __attribute__((address_space(3)))
typedef float f32x2 __attribute__((ext_vector_type(2)));
typedef unsigned u32x2 __attribute__((ext_vector_type(2)));

constexpr int DM = 2048, MX = 32768, MH = 4096, MT = 36864, NPROJ = 5376, DFF = 8192;
constexpr float EPSF = 1e-6f;
constexpr size_t WS_WIN = 0;
constexpr size_t WS_WOUT = WS_WIN + (size_t)5376 * 2048 * 2;
constexpr size_t WS_WUP = WS_WOUT + (size_t)2048 * 2048 * 2;
constexpr size_t WS_WDN = WS_WUP + (size_t)8192 * 2048 * 2;
constexpr size_t WS_MOD = WS_WDN + (size_t)8192 * 2048 * 2;
constexpr size_t WS_H = WS_MOD + (size_t)17 * 12288 * 4;
constexpr size_t WS_ABUF = WS_H + (size_t)MH * 2048 * 4;
constexpr size_t WS_AB = WS_ABUF + (size_t)MT * 2048 * 2;
constexpr size_t WS_PROJ = WS_AB + (size_t)MT * 32 * 4;
constexpr size_t WS_Q = WS_PROJ + (size_t)MT * NPROJ * 2;
constexpr size_t WS_K = WS_Q + (size_t)MT * 1024 * 2;
constexpr size_t WS_V = WS_K + (size_t)MT * 1024 * 2;
constexpr size_t WS_OB = WS_V + (size_t)MT * 1024 * 2;
constexpr size_t WS_XG = WS_OB + (size_t)MT * 1024 * 2;
constexpr size_t WS_SMG = WS_XG + (size_t)9216 * 4096 * 2;
constexpr size_t WS_END = WS_SMG + (size_t)9216 * 128 * 4;
constexpr size_t WS_HID = WS_PROJ;
static_assert(WS_HID + (size_t)MT * DFF * 2 <= WS_XG, "hidden overlay");
static_assert(WS_END <= (size_t)1 << 30, "workspace");
constexpr int LDS_BYTES = 155648;

struct Args { const float* in[19]; float* out; unsigned char* ws; int ph_lo, ph_hi, pad0, pad1; };

__device__ __forceinline__ float bf_lo(unsigned w) { return __uint_as_float(w << 16); }
__device__ __forceinline__ float bf_hi(unsigned w) { return __uint_as_float(w & 0xffff0000u); }
__device__ __forceinline__ float wave_sum(float v) {
#pragma unroll
    for (int o = 1; o < 64; o <<= 1) v += __shfl_xor(v, o);
    return v;
}
__device__ __forceinline__ float silu_f(float x) { return x * __builtin_amdgcn_rcpf(1.f + __expf(-x)); }
__device__ __forceinline__ void unpack8(const u32x4 p, float (&f)[8]) {
    f[0] = bf_lo(p.x); f[1] = bf_hi(p.x); f[2] = bf_lo(p.y); f[3] = bf_hi(p.y); f[4] = bf_lo(p.z); f[5] = bf_hi(p.z); f[6] = bf_lo(p.w); f[7] = bf_hi(p.w);
}
__device__ __forceinline__ u32x4 pack8(const float (&f)[8]) {
    u32x4 o; o.x = cvt_pk_bf16(f[0], f[1]); o.y = cvt_pk_bf16(f[2], f[3]); o.z = cvt_pk_bf16(f[4], f[5]); o.w = cvt_pk_bf16(f[6], f[7]); return o;
}
__device__ __forceinline__ u32x2 pack4(const f32x4 v) { u32x2 o; o.x = cvt_pk_bf16(v[0], v[1]); o.y = cvt_pk_bf16(v[2], v[3]); return o; }
#define LDS_WAIT() asm volatile("s_waitcnt lgkmcnt(0)" ::: "memory")
template <class T> __device__ __forceinline__ T ld_nt(const T* p) { return __builtin_nontemporal_load(p); }
template <class T> __device__ __forceinline__ void st_nt(T* p, const T v) { __builtin_nontemporal_store(v, p); }
#define BAR_LDS() do { asm volatile("s_waitcnt lgkmcnt(0)" ::: "memory"); __builtin_amdgcn_s_barrier(); asm volatile("" ::: "memory"); } while (0)
#define MFMA16(a, b, c) __builtin_amdgcn_mfma_f32_16x16x32_bf16((a), (b), (c), 0, 0, 0)

struct EpiProj {
    static constexpr bool PERM = true, AFTER_DRAIN = false;
    bf16_t* P;
    __device__ __forceinline__ void operator()(const f32x4 (&acc)[2][2][4][2], const pg8::Unit& u, int wr, int wc, int fr, int fq) const {
        const int row0 = u.pm * 256 + wr * 64 + fr;
        const int col0 = u.pn * 256 + wc * 32 + 8 * fq;
#pragma unroll
        for (int ai = 0; ai < 2; ++ai)
#pragma unroll
            for (int m = 0; m < 4; ++m) { bf16_t* rowp = P + (size_t)(row0 + ai * 128 + m * 16) * NPROJ + col0;
#pragma unroll
                for (int bj = 0; bj < 2; ++bj) { const f32x4 v0 = acc[ai][bj][m][0], v1 = acc[ai][bj][m][1];
                    u32x4 w; w.x = cvt_pk_bf16(v0[0], v0[1]); w.y = cvt_pk_bf16(v0[2], v0[3]); w.z = cvt_pk_bf16(v1[0], v1[1]); w.w = cvt_pk_bf16(v1[2], v1[3]);
                    *(u32x4*)(rowp + bj * 128) = w; } }
    }
};
struct EpiRes {
    static constexpr bool PERM = false, AFTER_DRAIN = false;
    const float* xsrc; float* xdst; const float* hsrc; float* hdst; const float* gate0;
    __device__ __forceinline__ void operator()(const f32x4 (&acc)[2][2][4][2], const pg8::Unit& u, int wr, int wc, int fr, int fq) const {
        const bool isx = u.pm < 128;
        const float* src = isx ? xsrc + (size_t)u.pm * 256 * DM : hsrc + (size_t)(u.pm - 128) * 256 * DM;
        float* dst = isx ? xdst + (size_t)u.pm * 256 * DM : hdst + (size_t)(u.pm - 128) * 256 * DM;
        const float* gate = gate0 + (size_t)(isx ? (u.pm >> 3) : 16) * 12288;
        const int rl0 = wr * 64 + fr, col0 = u.pn * 256 + wc * 32 + 4 * fq;
        f32x4 gv[2][2];
#pragma unroll
        for (int bj = 0; bj < 2; ++bj)
#pragma unroll
            for (int n = 0; n < 2; ++n) gv[bj][n] = *(const f32x4*)(gate + col0 + bj * 128 + n * 16);
#pragma unroll
        for (int ai = 0; ai < 2; ++ai)
#pragma unroll
            for (int m = 0; m < 4; ++m) { const size_t off = (size_t)(rl0 + ai * 128 + m * 16) * DM + col0;
#pragma unroll
                for (int bj = 0; bj < 2; ++bj)
#pragma unroll
                    for (int n = 0; n < 2; ++n) { const f32x4 s = *(const f32x4*)(src + off + bj * 128 + n * 16);
                        *(f32x4*)(dst + off + bj * 128 + n * 16) = s + gv[bj][n] * acc[ai][bj][m][n]; } }
    }
};
struct EpiUp {
    static constexpr bool PERM = true, AFTER_DRAIN = false;
    bf16_t* Hd;
    __device__ __forceinline__ void operator()(const f32x4 (&acc)[2][2][4][2], const pg8::Unit& u, int wr, int wc, int fr, int fq) const {
        const int row0 = u.pm * 256 + wr * 64 + fr, col0 = u.pn * 256 + wc * 32 + 8 * fq;
#pragma unroll
        for (int ai = 0; ai < 2; ++ai)
#pragma unroll
            for (int m = 0; m < 4; ++m) { bf16_t* rowp = Hd + (size_t)(row0 + ai * 128 + m * 16) * DFF + col0;
#pragma unroll
                for (int bj = 0; bj < 2; ++bj) { f32x4 v0 = acc[ai][bj][m][0], v1 = acc[ai][bj][m][1];
#pragma unroll
                    for (int e = 0; e < 4; ++e) { const float a0 = fmaxf(v0[e], 0.f), a1 = fmaxf(v1[e], 0.f); v0[e] = a0 * a0; v1[e] = a1 * a1; }
                    u32x4 w; w.x = cvt_pk_bf16(v0[0], v0[1]); w.y = cvt_pk_bf16(v0[2], v0[3]); w.z = cvt_pk_bf16(v1[0], v1[1]); w.w = cvt_pk_bf16(v1[2], v1[3]);
                    st_nt((u32x4*)(rowp + bj * 128), w); } }
    }
};

struct L1Order {
    pg8::StaticOrder base; int G, c;
    __device__ void init(int G_, int c_) { base.init(MX, 5376, G_, c_); G = G_; c = c_; }
    __device__ bool next(int i, pg8::Unit& u) const {
        const long Lq = (long)i * G + c; if (Lq < base.nwg) return base.next(i, u);
        const int idx = (int)(Lq - base.nwg); if (idx >= 128) return false;
        u.pm = 128 + (idx >> 3); u.pn = 4 + (idx & 7); u.ko = 0; return true; }
    __device__ __forceinline__ void a_ready(const pg8::Unit&) const {}
    __device__ __forceinline__ void done(const pg8::Unit&) const {}
};
struct CtxSplitOrder {
    int G, c;
    __device__ bool next(int i, pg8::Unit& u) const { const long Lq = (long)i * G + c; if (Lq >= 256) return false; const int t = (int)Lq >> 1; u.pm = t >> 3; u.pn = t & 7; u.ko = ((int)Lq & 1) * 8192; return true; }
    __device__ __forceinline__ void a_ready(const pg8::Unit&) const {}
    __device__ __forceinline__ void done(const pg8::Unit&) const {}
};
struct EpiCtxSplit {
    static constexpr bool PERM = false, AFTER_DRAIN = false;
    float* h; float* hadd; const float* gate;
    __device__ __forceinline__ void operator()(const f32x4 (&acc)[2][2][4][2], const pg8::Unit& u, int wr, int wc, int fr, int fq) const {
        float* dst = (u.ko ? hadd : h) + (size_t)u.pm * 256 * DM;
        const int rl0 = wr * 64 + fr, col0 = u.pn * 256 + wc * 32 + 4 * fq;
        f32x4 gv[2][2];
#pragma unroll
        for (int bj = 0; bj < 2; ++bj)
#pragma unroll
            for (int n = 0; n < 2; ++n) gv[bj][n] = *(const f32x4*)(gate + col0 + bj * 128 + n * 16);
#pragma unroll
        for (int ai = 0; ai < 2; ++ai)
#pragma unroll
            for (int m = 0; m < 4; ++m) { const size_t off = (size_t)(rl0 + ai * 128 + m * 16) * DM + col0;
#pragma unroll
                for (int bj = 0; bj < 2; ++bj)
#pragma unroll
                    for (int n = 0; n < 2; ++n) { f32x4 v = gv[bj][n] * acc[ai][bj][m][n];
                        if (u.ko == 0) v += *(const f32x4*)(dst + off + bj * 128 + n * 16);
                        *(f32x4*)(dst + off + bj * 128 + n * 16) = v; } }
    }
};

__device__ __forceinline__ void tr_item(const float* W, int ldw, int srccol0, bf16_t* WT, int Kd, int dstrow0, int k0, LAS float* scr, int lane) {
    float tv[32];
#pragma unroll
    for (int i = 0; i < 32; ++i) tv[i] = W[(size_t)(k0 + 2 * i + (lane >> 5)) * ldw + srccol0 + (lane & 31)];
#pragma unroll
    for (int i = 0; i < 32; ++i) scr[(2 * i + (lane >> 5)) * 33 + (lane & 31)] = tv[i];
    LDS_WAIT();
    const int c = lane & 7;
#pragma unroll
    for (int j = 0; j < 4; ++j) { const int n = (lane >> 3) + 8 * j; const LAS float* s = scr + (8 * c) * 33 + n;
        u32x4 o; o.x = cvt_pk_bf16(s[0 * 33], s[1 * 33]); o.y = cvt_pk_bf16(s[2 * 33], s[3 * 33]); o.z = cvt_pk_bf16(s[4 * 33], s[5 * 33]); o.w = cvt_pk_bf16(s[6 * 33], s[7 * 33]);
        *(u32x4*)(WT + (size_t)(dstrow0 + n) * Kd + k0 + 8 * c) = o; }
    LDS_WAIT();
}
__device__ __forceinline__ void p0_phase(const Args& a, int l, LAS unsigned char* L, int tid, int lane, int wave) {
    {
        const float* wada = a.in[4] + (size_t)l * 2048 * 12288; const float* bada = a.in[5] + (size_t)l * 12288;
        const float* cvec = a.in[1]; const float* cctx = a.in[3];
        float* MOD = (float*)(a.ws + WS_MOD);
        LAS float* scw = (LAS float*)(L + wave * 5120);
        LAS float* red = (LAS float*)(L + 40960);
        const int cg4 = lane & 15, rg = lane >> 4;
        for (int it = blockIdx.x; it < 192; it += gridDim.x) {
            const int c0 = it * 64;
            float acc[17][4];
#pragma unroll
            for (int b = 0; b < 17; ++b)
#pragma unroll
                for (int e = 0; e < 4; ++e) acc[b][e] = 0.f;
            for (int s = 0; s < 4; ++s) {
                const int kb = wave * 256 + s * 64;
#pragma unroll
                for (int b = 0; b < 17; ++b) { const float v = (b < 16) ? cvec[b * 2048 + kb + lane] : cctx[kb + lane]; scw[lane * 20 + b] = silu_f(v); }
                LDS_WAIT();
#pragma unroll 4
                for (int j = 0; j < 16; ++j) {
                    const int kk = 4 * j + rg;
                    const f32x4 w4 = *(const f32x4*)(wada + (size_t)(kb + kk) * 12288 + c0 + 4 * cg4);
                    const LAS float* sp = scw + kk * 20;
                    const f32x4 s0 = *(const LAS f32x4*)(sp), s1 = *(const LAS f32x4*)(sp + 4), s2 = *(const LAS f32x4*)(sp + 8), s3 = *(const LAS f32x4*)(sp + 12); const float s16 = sp[16];
#pragma unroll
                    for (int e = 0; e < 4; ++e) {
                        acc[0][e] += s0[0] * w4[e]; acc[1][e] += s0[1] * w4[e]; acc[2][e] += s0[2] * w4[e]; acc[3][e] += s0[3] * w4[e];
                        acc[4][e] += s1[0] * w4[e]; acc[5][e] += s1[1] * w4[e]; acc[6][e] += s1[2] * w4[e]; acc[7][e] += s1[3] * w4[e];
                        acc[8][e] += s2[0] * w4[e]; acc[9][e] += s2[1] * w4[e]; acc[10][e] += s2[2] * w4[e]; acc[11][e] += s2[3] * w4[e];
                        acc[12][e] += s3[0] * w4[e]; acc[13][e] += s3[1] * w4[e]; acc[14][e] += s3[2] * w4[e]; acc[15][e] += s3[3] * w4[e];
                        acc[16][e] += s16 * w4[e]; }
                }
                LDS_WAIT();
            }
#pragma unroll
            for (int b = 0; b < 17; ++b)
#pragma unroll
                for (int e = 0; e < 4; ++e) { float v = acc[b][e]; v += __shfl_xor(v, 16); v += __shfl_xor(v, 32); acc[b][e] = v; }
            if (rg == 0) {
#pragma unroll
                for (int b = 0; b < 17; ++b) *(LAS f32x4*)(red + (wave * 17 + b) * 64 + cg4 * 4) = (f32x4){acc[b][0], acc[b][1], acc[b][2], acc[b][3]};
            }
            __syncthreads();
            for (int idx = tid; idx < 17 * 64; idx += 512) { const int b = idx >> 6, cc = idx & 63; float s = bada[c0 + cc];
#pragma unroll
                for (int w = 0; w < 8; ++w) s += red[(w * 17 + b) * 64 + cc];
                MOD[(size_t)b * 12288 + c0 + cc] = s; }
            __syncthreads();
        }
    }
    {
        const float* w_in = a.in[8] + (size_t)l * 2048 * 5152; const float* w_out = a.in[15] + (size_t)l * 2048 * 2048;
        const float* w_up = a.in[16] + (size_t)l * 2048 * 8192; const float* w_dn = a.in[17] + (size_t)l * 8192 * 2048;
        const float* pool_w = a.in[13] + (size_t)l * 4 * 65536; const float* pscale = a.in[14] + (size_t)l * 1024;
        bf16_t* WTin = (bf16_t*)(a.ws + WS_WIN); bf16_t* WTout = (bf16_t*)(a.ws + WS_WOUT); bf16_t* WTup = (bf16_t*)(a.ws + WS_WUP); bf16_t* WTdn = (bf16_t*)(a.ws + WS_WDN);
        LAS float* scr = (LAS float*)(L + 81920 + wave * 8448);
        const int gw = blockIdx.x * 8 + wave, NGW = gridDim.x * 8;
        constexpr int N0 = 4096, N1 = 1024, N2 = 32, N3 = 1024, N4 = 8192, N5 = 8192, N6 = 2048;
        for (int it0 = gw; it0 < N0 + N1 + N2 + N3 + N4 + N5 + N6; it0 += NGW) {
            int it = it0;
            if (it < N0) { tr_item(w_in, 5152, 32 * (it & 127), WTin, 2048, 32 * (it & 127), 64 * (it >> 7), scr, lane); continue; } it -= N0;
            if (it < N1) { tr_item(w_in, 5152, 4128 + 32 * (it & 31), WTin, 2048, 4096 + 32 * (it & 31), 64 * (it >> 5), scr, lane); continue; } it -= N1;
            if (it < N2) { tr_item(w_in, 5152, 4096, WTin, 2048, 5120, 64 * it, scr, lane); continue; } it -= N2;
            if (it < N3) { tr_item(w_out, 2048, 32 * (it & 63), WTout, 2048, 32 * (it & 63), 64 * (it >> 6), scr, lane); continue; } it -= N3;
            if (it < N4) { tr_item(w_up, 8192, 32 * (it & 255), WTup, 2048, 32 * (it & 255), 64 * (it >> 8), scr, lane); continue; } it -= N4;
            if (it < N5) { tr_item(w_dn, 2048, 32 * (it & 63), WTdn, 8192, 32 * (it & 63), 64 * (it >> 6), scr, lane); continue; } it -= N5;
            const int g = it >> 9, rem = it & 511, n = 64 * (rem >> 4) + lane, j0 = 16 * (rem & 15);
            const float* wo = w_out + (size_t)(1024 + 256 * g) * 2048 + n; const float* pw = pool_w + (size_t)g * 65536 + j0 * 256; const float* ps = pscale + 256 * g;
            float acc[16];
#pragma unroll
            for (int jj = 0; jj < 16; ++jj) acc[jj] = 0.f;
            const float* pwl = pw + (lane >> 2) * 256 + (lane & 3) * 4;
            f32x4 pwn = *(const f32x4*)pwl; float wvn[16];
#pragma unroll
            for (int cc = 0; cc < 16; ++cc) wvn[cc] = wo[(size_t)cc * 2048];
            for (int cb = 0; cb < 256; cb += 16) {
                const f32x4 pwv = pwn; float wv[16];
#pragma unroll
                for (int cc = 0; cc < 16; ++cc) wv[cc] = wvn[cc] * ps[cb + cc];
                if (cb + 16 < 256) { pwn = *(const f32x4*)(pwl + cb + 16);
#pragma unroll
                    for (int cc = 0; cc < 16; ++cc) wvn[cc] = wo[(size_t)(cb + 16 + cc) * 2048]; }
                *(LAS f32x4*)(scr + (lane >> 2) * 16 + (lane & 3) * 4) = pwv;
                LDS_WAIT();
#pragma unroll
                for (int cc4 = 0; cc4 < 4; ++cc4)
#pragma unroll
                    for (int jj = 0; jj < 16; ++jj) { const f32x4 m = *(const LAS f32x4*)(scr + jj * 16 + cc4 * 4);
                        acc[jj] += (m[0] * wv[4 * cc4] + m[1] * wv[4 * cc4 + 1]) + (m[2] * wv[4 * cc4 + 2] + m[3] * wv[4 * cc4 + 3]); }
                LDS_WAIT();
            }
            bf16_t* dst = WTout + (size_t)n * 2048 + 1024 + 256 * g + j0;
            u32x4 o0, o1; o0.x = cvt_pk_bf16(acc[0], acc[1]); o0.y = cvt_pk_bf16(acc[2], acc[3]); o0.z = cvt_pk_bf16(acc[4], acc[5]); o0.w = cvt_pk_bf16(acc[6], acc[7]);
            o1.x = cvt_pk_bf16(acc[8], acc[9]); o1.y = cvt_pk_bf16(acc[10], acc[11]); o1.z = cvt_pk_bf16(acc[12], acc[13]); o1.w = cvt_pk_bf16(acc[14], acc[15]);
            *(u32x4*)dst = o0; *(u32x4*)(dst + 8) = o1;
        }
    }
}

__device__ __forceinline__ void norm_phase(const float* xsrc, const float* hsrc, const float* hadd, int nrows, const float* nw, const float* MOD, int shift_idx, bf16_t* out, int gw, int NGW, int lane) {
    const int RPW = (nrows + NGW - 1) / NGW, rb = (gw >> 3) * (RPW * 8) + (gw & 7), r1 = min((gw >> 3) * (RPW * 8) + RPW * 8, nrows);
    if (rb >= r1) return;
    f32x4 Aa[8], Bb[8], v[8], vn[8]; int curmod = -1;
    { const float* src = (rb < MX) ? xsrc + (size_t)rb * DM : hsrc + (size_t)(rb - MX) * DM;
#pragma unroll
      for (int j = 0; j < 8; ++j) vn[j] = *(const f32x4*)(src + 4 * lane + 256 * j); }
    for (int r = rb; r < r1; r += 8) {
#pragma unroll
        for (int j = 0; j < 8; ++j) v[j] = vn[j];
        if (hadd && r >= MX) {
#pragma unroll
            for (int j = 0; j < 8; ++j) v[j] += *(const f32x4*)(hadd + (size_t)(r - MX) * DM + 4 * lane + 256 * j); }
        if (r + 8 < r1) { const float* src = (r + 8 < MX) ? xsrc + (size_t)(r + 8) * DM : hsrc + (size_t)(r + 8 - MX) * DM;
#pragma unroll
            for (int j = 0; j < 8; ++j) vn[j] = *(const f32x4*)(src + 4 * lane + 256 * j); }
        const int modrow = (r < MX) ? (r >> 11) : 16;
        if (modrow != curmod) { curmod = modrow;
            const float* sh = MOD + (size_t)modrow * 12288 + shift_idx * 2048; const float* sc = sh + 2048;
#pragma unroll
            for (int j = 0; j < 8; ++j) { const int c = 4 * lane + 256 * j; Aa[j] = *(const f32x4*)(nw + c) * (1.f + *(const f32x4*)(sc + c)); Bb[j] = *(const f32x4*)(sh + c); } }
        float ss = 0.f;
#pragma unroll
        for (int j = 0; j < 8; ++j) ss += (v[j][0] * v[j][0] + v[j][1] * v[j][1]) + (v[j][2] * v[j][2] + v[j][3] * v[j][3]);
        ss = wave_sum(ss);
        const float rstd = rsqrtf(ss * (1.f / 2048.f) + EPSF);
#pragma unroll
        for (int j = 0; j < 8; ++j) { const f32x4 y = (v[j] * rstd) * Aa[j] + Bb[j]; *(u32x2*)(out + (size_t)r * DM + 4 * lane + 256 * j) = pack4(y); }
    }
}
__device__ __forceinline__ void final_norm_phase(float* x, const float* nw, int gw, int NGW, int lane) {
    const int RPW = (MX + NGW - 1) / NGW, rb = (gw >> 3) * (RPW * 8) + (gw & 7), r1 = min((gw >> 3) * (RPW * 8) + RPW * 8, MX);
    if (rb >= r1) return;
    f32x4 Aa[8], v[8], vn[8];
#pragma unroll
    for (int j = 0; j < 8; ++j) { Aa[j] = *(const f32x4*)(nw + 4 * lane + 256 * j); vn[j] = *(const f32x4*)(x + (size_t)rb * DM + 4 * lane + 256 * j); }
    for (int r = rb; r < r1; r += 8) {
#pragma unroll
        for (int j = 0; j < 8; ++j) v[j] = vn[j];
        if (r + 8 < r1) {
#pragma unroll
            for (int j = 0; j < 8; ++j) vn[j] = *(const f32x4*)(x + (size_t)(r + 8) * DM + 4 * lane + 256 * j); }
        float ss = 0.f;
#pragma unroll
        for (int j = 0; j < 8; ++j) ss += (v[j][0] * v[j][0] + v[j][1] * v[j][1]) + (v[j][2] * v[j][2] + v[j][3] * v[j][3]);
        ss = wave_sum(ss);
        const float rstd = rsqrtf(ss * (1.f / 2048.f) + EPSF);
#pragma unroll
        for (int j = 0; j < 8; ++j) *(f32x4*)(x + (size_t)r * DM + 4 * lane + 256 * j) = v[j] * rstd * Aa[j];
    }
}

__device__ __forceinline__ void prep_phase(const Args& a, int l, LAS unsigned char* L, int tid, int lane, int wave) {
    const bf16_t* PROJ = (const bf16_t*)(a.ws + WS_PROJ); bf16_t* ABUF = (bf16_t*)(a.ws + WS_ABUF);
    bf16_t* Qb = (bf16_t*)(a.ws + WS_Q); bf16_t* Kb = (bf16_t*)(a.ws + WS_K); bf16_t* Vb = (bf16_t*)(a.ws + WS_V);
    const float* convw = a.in[9] + (size_t)l * 5 * 3072;
    const int gw = blockIdx.x * 8 + wave, NGW = gridDim.x * 8;
    if (gw < 2046) {
        const int cs = gw % 6, w = cs >> 1, hh = cs & 1, col = w * 1024 + hh * 512 + lane * 8;
        float cw[5][8];
#pragma unroll
        for (int i = 0; i < 5; ++i) { const f32x4 c0 = *(const f32x4*)(convw + i * 3072 + col), c1 = *(const f32x4*)(convw + i * 3072 + col + 4);
            cw[i][0] = c0[0]; cw[i][1] = c0[1]; cw[i][2] = c0[2]; cw[i][3] = c0[3]; cw[i][4] = c1[0]; cw[i][5] = c1[1]; cw[i][6] = c1[2]; cw[i][7] = c1[3]; }
        bf16_t* dstb = (w == 0 ? Qb : (w == 1 ? Kb : Vb)) + hh * 512 + lane * 8;
        const float qs = (w == 0) ? 0.08838834764831845f : 1.f;
        for (int seg = gw / 6; seg < MT / 16; seg += 341) {
            const int r0 = seg * 16;
            if (l == 1 && r0 >= MX && w == 0) continue;
            int t0, T; if (r0 < MX) { t0 = r0 & 2047; T = 2048; } else { t0 = (r0 - MX) & 255; T = 256; }
            u32x4 win[20];
#pragma unroll
            for (int k = 0; k < 20; ++k) { const int tt = t0 + k - 2;
                win[k] = (tt >= 0 && tt < T) ? *(const u32x4*)(PROJ + (size_t)(r0 + k - 2) * NPROJ + col) : (u32x4){0u, 0u, 0u, 0u}; }
#pragma unroll
            for (int i = 0; i < 16; ++i) {
                float acc[8];
#pragma unroll
                for (int e = 0; e < 8; ++e) acc[e] = 0.f;
#pragma unroll
                for (int k = 0; k < 5; ++k) { float pz[8]; unpack8(win[i + k], pz);
#pragma unroll
                    for (int e = 0; e < 8; ++e) acc[e] += pz[e] * cw[k][e]; }
#pragma unroll
                for (int e = 0; e < 8; ++e) acc[e] = silu_f(acc[e]);
                if (w < 2) { float ss = 0.f;
#pragma unroll
                    for (int e = 0; e < 8; ++e) ss += acc[e] * acc[e];
                    ss += __shfl_xor(ss, 1); ss += __shfl_xor(ss, 2); ss += __shfl_xor(ss, 4); ss += __shfl_xor(ss, 8);
                    const float sc = rsqrtf(ss + EPSF) * qs;
#pragma unroll
                    for (int e = 0; e < 8; ++e) acc[e] *= sc; }
                *(u32x4*)(dstb + (size_t)(r0 + i) * 1024) = pack8(acc);
            }
        }
    }
    {
        LAS float* R = (LAS float*)L; LAS float* V = (LAS float*)(L + 65536);
#define POOL_GEO(it) const int b = (it) >> 7, cb = ((it) >> 2) & 31, gi = ((it) + ((it) >> 8)) & 3, col = 4096 + gi * 256 + cb * 8, s2 = 1 << gi
        u32x4 pvn[4];
        if ((int)blockIdx.x < 2048) { POOL_GEO((int)blockIdx.x);
#pragma unroll
            for (int rep = 0; rep < 4; ++rep) pvn[rep] = *(const u32x4*)(PROJ + (size_t)(b * 2048 + tid + 512 * rep) * NPROJ + col); (void)s2; }
        for (int it = blockIdx.x; it < 2048; it += gridDim.x) {
            POOL_GEO(it);
#pragma unroll
            for (int rep = 0; rep < 4; ++rep) { const int tok = tid + 512 * rep; float p[8]; unpack8(pvn[rep], p);
                *(LAS f32x4*)(R + tok * 8) = (f32x4){p[0], p[1], p[2], p[3]}; *(LAS f32x4*)(R + tok * 8 + 4) = (f32x4){p[4], p[5], p[6], p[7]}; }
            { const int itn = it + gridDim.x;
              if (itn < 2048) { const int bn = itn >> 7, cbn = (itn >> 2) & 31, gin = (itn + (itn >> 8)) & 3, coln = 4096 + gin * 256 + cbn * 8;
#pragma unroll
                  for (int rep = 0; rep < 4; ++rep) pvn[rep] = *(const u32x4*)(PROJ + (size_t)(bn * 2048 + tid + 512 * rep) * NPROJ + coln); } }
            BAR_LDS();
#pragma unroll
            for (int rep = 0; rep < 4; ++rep) { const int tok = tid + 512 * rep, y = tok >> 6, x = tok & 63;
                const int lo = max(y - s2, 0), hi = min(y + s2 - 1, 31);
                f32x4 a0 = (f32x4){0.f, 0.f, 0.f, 0.f}, a1 = a0;
                for (int yy = lo; yy <= hi; ++yy) { a0 += *(const LAS f32x4*)(R + (yy * 64 + x) * 8); a1 += *(const LAS f32x4*)(R + (yy * 64 + x) * 8 + 4); }
                const float inv = 1.f / (float)(hi - lo + 1);
                *(LAS f32x4*)(V + tok * 8) = a0 * inv; *(LAS f32x4*)(V + tok * 8 + 4) = a1 * inv; }
            BAR_LDS();
#pragma unroll
            for (int rep = 0; rep < 4; ++rep) { const int tok = tid + 512 * rep, y = tok >> 6, x = tok & 63;
                const int lo = max(x - s2, 0), hi = min(x + s2 - 1, 63);
                f32x4 a0 = (f32x4){0.f, 0.f, 0.f, 0.f}, a1 = a0;
                for (int xx = lo; xx <= hi; ++xx) { a0 += *(const LAS f32x4*)(V + (y * 64 + xx) * 8); a1 += *(const LAS f32x4*)(V + (y * 64 + xx) * 8 + 4); }
                const float inv = 1.f / (float)(hi - lo + 1);
                const f32x4 r0 = *(const LAS f32x4*)(R + tok * 8), r1 = *(const LAS f32x4*)(R + tok * 8 + 4);
                const f32x4 o0 = a0 * inv - r0, o1 = a1 * inv - r1;
                u32x4 o; o.x = cvt_pk_bf16(o0[0], o0[1]); o.y = cvt_pk_bf16(o0[2], o0[3]); o.z = cvt_pk_bf16(o1[0], o1[1]); o.w = cvt_pk_bf16(o1[2], o1[3]);
                *(u32x4*)(ABUF + (size_t)(b * 2048 + tok) * DM + 1024 + gi * 256 + cb * 8) = o; }
            BAR_LDS();
        }
    }
    if (l == 1) {
        const bf16_t* WTin = (const bf16_t*)(a.ws + WS_WIN); bf16_t* PROJw = (bf16_t*)(a.ws + WS_PROJ);
        for (int r = MX + gw; r < MT; r += NGW) {
            float xv[32];
#pragma unroll
            for (int j = 0; j < 4; ++j) { float t8[8]; unpack8(*(const u32x4*)(ABUF + (size_t)r * DM + 8 * lane + 512 * j), t8);
#pragma unroll
                for (int e = 0; e < 8; ++e) xv[8 * j + e] = t8[e]; }
            float res = 0.f;
            for (int o = 0; o < 32; ++o) {
                float s = 0.f;
#pragma unroll
                for (int j = 0; j < 4; ++j) { float t8[8]; unpack8(*(const u32x4*)(WTin + (size_t)(5120 + o) * 2048 + 8 * lane + 512 * j), t8);
#pragma unroll
                    for (int e = 0; e < 8; ++e) s += t8[e] * xv[8 * j + e]; }
                s = wave_sum(s);
                if (lane == o) res = s;
            }
            if (lane < 32) PROJw[(size_t)r * NPROJ + 5120 + lane] = (bf16_t)(cvt_pk_bf16(res, 0.f) & 0xffffu);
        }
    }
    if (l == 0) {
        const int gt = blockIdx.x * 512 + tid, NT = gridDim.x * 512;
        for (int idx = gt; idx < MH * 128; idx += NT) {
            const int rr = idx >> 7, ch = idx & 127, gi = ch >> 5, s2 = 1 << gi, t = rr & 255, base = MX + rr - t;
            const int lo = max(t - s2, 0), hi = min(t + s2 - 1, 255);
            float s[8];
#pragma unroll
            for (int e = 0; e < 8; ++e) s[e] = 0.f;
            for (int tt = lo; tt <= hi; ++tt) { const u32x4 pv = *(const u32x4*)(PROJ + (size_t)(base + tt) * NPROJ + 4096 + ch * 8); float p[8]; unpack8(pv, p);
#pragma unroll
                for (int e = 0; e < 8; ++e) s[e] += p[e]; }
            const float inv = 1.f / (float)(hi - lo + 1);
            const u32x4 pv = *(const u32x4*)(PROJ + (size_t)(base + t) * NPROJ + 4096 + ch * 8); float p[8]; unpack8(pv, p);
#pragma unroll
            for (int e = 0; e < 8; ++e) s[e] = s[e] * inv - p[e];
            *(u32x4*)(ABUF + (size_t)(base + t) * DM + 1024 + ch * 8) = pack8(s);
        }
    }
}

__device__ __forceinline__ float softplus_f(float yy) { const float zz = __expf(fminf(yy, 20.f)); return (yy > 20.f) ? yy : ((zz < 1e-3f) ? zz * (1.f - 0.5f * zz) : __logf(1.f + zz)); }
__device__ __forceinline__ void xinv_phase(const Args& a, int l, LAS unsigned char* L, int tid0, int wave) {
    const bf16_t* Kb = (const bf16_t*)(a.ws + WS_K); const bf16_t* PROJ = (const bf16_t*)(a.ws + WS_PROJ); bf16_t* XG = (bf16_t*)(a.ws + WS_XG);
    const f32x4 z4 = (f32x4){0.f, 0.f, 0.f, 0.f};
    for (int seq = blockIdx.x; seq < 256; seq += gridDim.x) {
        const int b = seq >> 4, h = (seq >> 1) & 7, dir = seq & 1;
        const float nega_h = -__expf(a.in[10][l * 16 + dir * 8 + h]), dtb_h = a.in[11][l * 16 + dir * 8 + h];
        for (int ci = wave; ci < 36; ci += 8) {
            int tid_o = tid0; LAS unsigned char* Lm = L + wave * 17408; asm volatile("" : "+v"(tid_o), "+v"(Lm));
            const int lane = tid_o & 63, r = lane & 15, q = lane >> 4;
            int lane_o = lane;
            const bool isctx = ci < 4; const int n = isctx ? ci : ci - 4, T = isctx ? 256 : 2048;
            const int rowbase = isctx ? MX + b * 256 : b * 2048;
            const int tok0 = dir ? T - 64 * (n + 1) : 64 * n;
            const int tokl = tok0 + (dir ? 63 - lane : lane);
            const bf16_t* abp = PROJ + (size_t)(rowbase + tokl) * NPROJ + 5120;
            float gc = nega_h * softplus_f(bf_lo(abp[dir * 8 + h]) + dtb_h);
            const float bt = 1.f / (1.f + __expf(-bf_lo(abp[16 + dir * 8 + h])));
#pragma unroll
            for (int o = 1; o < 64; o <<= 1) { const float tv = __shfl_up(gc, o); if (lane >= o) gc += tv; }
            { float* smg = (float*)(a.ws + WS_SMG) + (size_t)(seq * 36 + ci) * 128; smg[lane] = gc; smg[64 + lane] = bt; }
            bf16x8 f[4][4];
#pragma unroll
            for (int t = 0; t < 4; ++t) { const int i = 16 * t + r, tok = tok0 + (dir ? 63 - i : i);
                const bf16_t* kp = Kb + (size_t)(rowbase + tok) * 1024 + h * 128 + 8 * q;
#pragma unroll
                for (int s = 0; s < 4; ++s) f[t][s] = *(const bf16x8*)(kp + 32 * s); }
#pragma unroll
            for (int tj = 0; tj < 4; ++tj) {
                const int j = 16 * tj + r; const float gcj = __shfl(gc, j);
#pragma unroll
                for (int ti = tj; ti < 4; ++ti) {
                    f32x4 acc = z4;
#pragma unroll
                    for (int s = 0; s < 4; ++s) acc = MFMA16(f[ti][s], f[tj][s], acc);
                    const int i0 = 16 * ti + 4 * q; f32x4 o;
#pragma unroll
                    for (int e = 0; e < 4; ++e) { const float gci = __shfl(gc, i0 + e), bi = __shfl(bt, i0 + e); o[e] = (i0 + e > j) ? acc[e] * bi * __expf(gci - gcj) : 0.f; }
                    *(LAS f32x4*)(Lm + j * 272 + i0 * 4) = o;
                }
            }
            LDS_WAIT();
            asm volatile("" : "+v"(lane_o), "+v"(Lm));
            f32x2 xp[32];
#pragma unroll
            for (int k = 0; k < 32; ++k) xp[k] = (f32x2){0.f, 0.f};
#pragma unroll
            for (int j = 63; j >= 0; --j) {
                f32x2 acc2 = (f32x2){(lane_o == j) ? 1.f : 0.f, 0.f};
#pragma unroll
                for (int k4 = ((j + 1) & ~3); k4 < 64; k4 += 4) {
                    const f32x4 m = *(const LAS f32x4*)(Lm + j * 272 + k4 * 4);
                    acc2 -= xp[k4 >> 1] * (f32x2){m[0], m[1]};
                    acc2 -= xp[(k4 >> 1) + 1] * (f32x2){m[2], m[3]};
                }
                float xj = acc2[0] + acc2[1];
                asm volatile("" : "+v"(xj), "+v"(Lm), "+v"(lane_o));
                xp[j >> 1][j & 1] = xj;
            }
            LDS_WAIT();
            bf16_t* xo = XG + ((size_t)(seq * 36 + ci) * 64 + lane) * 64;
#pragma unroll
            for (int j8 = 0; j8 < 8; ++j8) {
                float v2[8];
#pragma unroll
                for (int e = 0; e < 8; ++e) { const int j = 8 * j8 + e; v2[e] = xp[j >> 1][j & 1] * __builtin_bit_cast(float, __builtin_amdgcn_readlane(__builtin_bit_cast(int, bt), j)); }
                *(u32x4*)(xo + 8 * j8) = pack8(v2);
            }
        }
    }
}

constexpr int SC_ST = 0, SC_QR = 34816, SC_KR = 52224, SC_A2 = 69632, SC_KT = 78848, SC_VT = 97280, SC_WR = 115712, SC_AT = 133120, SC_SM = 142336;
constexpr int SC_VNT = SC_KR, SC_VNS = SC_VT;
__device__ __forceinline__ bf16x8 ldfrag(const LAS unsigned char* p) { return *(const LAS bf16x8*)p; }
__device__ __forceinline__ bf16x8 scale8(const bf16x8 v, const f32x4 e0, const f32x4 e1) {
    float f[8]; unpack8(__builtin_bit_cast(u32x4, v), f);
    f[0] *= e0[0]; f[1] *= e0[1]; f[2] *= e0[2]; f[3] *= e0[3]; f[4] *= e1[0]; f[5] *= e1[1]; f[6] *= e1[2]; f[7] *= e1[3];
    return __builtin_bit_cast(bf16x8, pack8(f));
}
struct ChunkGeo { int rowbase, tok0; bool want_o; };
__device__ __forceinline__ ChunkGeo chunk_geo(int ci, int b, int dir, int l) {
    ChunkGeo g; const bool isctx = ci < 4; const int n = isctx ? ci : ci - 4, T = isctx ? 256 : 2048;
    g.rowbase = isctx ? MX + b * 256 : b * 2048; g.tok0 = dir ? T - 64 * (n + 1) : 64 * n; g.want_o = (!isctx) || (l == 0); return g;
}
__device__ __forceinline__ void scan_phase(const Args& a, int l, LAS unsigned char* L, int tid0, int lane0, int wave) {
    const bf16_t* Qb = (const bf16_t*)(a.ws + WS_Q); const bf16_t* Kb = (const bf16_t*)(a.ws + WS_K); const bf16_t* Vb = (const bf16_t*)(a.ws + WS_V);
    const bf16_t* PROJ = (const bf16_t*)(a.ws + WS_PROJ); const bf16_t* XG = (const bf16_t*)(a.ws + WS_XG);
    bf16_t* ABUF = (bf16_t*)(a.ws + WS_ABUF); bf16_t* OB = (bf16_t*)(a.ws + WS_OB);
    LAS float* SM = (LAS float*)(L + SC_SM);
    const f32x4 z4 = (f32x4){0.f, 0.f, 0.f, 0.f};
    for (int seq = blockIdx.x; seq < 256; seq += gridDim.x) {
        const int b = seq >> 4, h = (seq >> 1) & 7, dir = seq & 1;
        const float nega_h = -__expf(a.in[10][l * 16 + dir * 8 + h]), dtb_h = a.in[11][l * 16 + dir * 8 + h];
        f32x4 S[8];
#pragma unroll
        for (int t = 0; t < 8; ++t) S[t] = z4;
        __syncthreads();
        for (int x = lane0; x < 16 * 68; x += 64) ((LAS unsigned*)(L + SC_ST + (16 * wave) * 272))[x] = 0u;
        u32x4 pq[2], pk[2], pv[2], px; float pa = 0.f, pb = 0.f;
        {
            const ChunkGeo g = chunk_geo(0, b, dir, l);
#pragma unroll
            for (int rep = 0; rep < 2; ++rep) { const int row = (tid0 >> 4) + 32 * rep, c8 = (tid0 & 15) * 8, tok = g.tok0 + (dir ? 63 - row : row);
                const size_t go = (size_t)(g.rowbase + tok) * 1024 + h * 128 + c8;
                pk[rep] = *(const u32x4*)(Kb + go); pv[rep] = *(const u32x4*)(Vb + go); pq[rep] = g.want_o ? *(const u32x4*)(Qb + go) : (u32x4){0u, 0u, 0u, 0u}; }
            px = *(const u32x4*)(XG + (size_t)(seq * 36 + 0) * 4096 + tid0 * 8);
            if (wave == 0) { const float* smg = (const float*)(a.ws + WS_SMG) + (size_t)(seq * 36 + 0) * 128; pa = smg[lane0]; pb = smg[64 + lane0]; }
        }
        for (int ci = 0; ci < 36; ++ci) {
            int tid_o = tid0; asm volatile("" : "+v"(tid_o));
            const int tid = tid_o, lane = tid & 63, r = lane & 15, q = lane >> 4;
            const ChunkGeo cg0 = chunk_geo(ci, b, dir, l);
            bf16x8 idf;
#pragma unroll
            for (int jj = 0; jj < 8; ++jj) idf[jj] = (8 * q + jj == 16 * (wave & 1) + r) ? (short)0x3F80 : (short)0;
            const int rowbase = cg0.rowbase, tok0 = cg0.tok0; const bool want_o = cg0.want_o;
            BAR_LDS();
#pragma unroll
            for (int rep = 0; rep < 2; ++rep) {
                const int row = (tid >> 4) + 32 * rep, c8 = (tid & 15) * 8;
                const u32x4 kv = pk[rep], vv = pv[rep];
                if (want_o) *(LAS u32x4*)(L + SC_QR + row * 272 + c8 * 2) = pq[rep];
                *(LAS u32x4*)(L + SC_KR + row * 272 + c8 * 2) = kv;
                *(LAS u32x4*)(L + SC_WR + row * 272 + c8 * 2) = vv;
            }
            *(LAS u32x4*)(L + SC_A2 + (tid >> 3) * 144 + (tid & 7) * 16) = px;
            if (wave == 0) {
                const float gc = pa, bt = pb;
                const float glast = __shfl(gc, 63);
                SM[lane] = gc; SM[64 + lane] = bt; SM[128 + lane] = __expf(gc); SM[192 + lane] = __expf(glast - gc);
                if (lane == 0) SM[256] = __expf(glast);
            }
            if (ci + 1 < 36) {
                const ChunkGeo g = chunk_geo(ci + 1, b, dir, l);
#pragma unroll
                for (int rep = 0; rep < 2; ++rep) { const int row = (tid >> 4) + 32 * rep, c8 = (tid & 15) * 8, tok = g.tok0 + (dir ? 63 - row : row);
                    const size_t go = (size_t)(g.rowbase + tok) * 1024 + h * 128 + c8;
                    pk[rep] = *(const u32x4*)(Kb + go); pv[rep] = *(const u32x4*)(Vb + go); if (g.want_o) pq[rep] = *(const u32x4*)(Qb + go); }
                px = *(const u32x4*)(XG + (size_t)(seq * 36 + ci + 1) * 4096 + tid * 8);
                if (wave == 0) { const float* smg = (const float*)(a.ws + WS_SMG) + (size_t)(seq * 36 + ci + 1) * 128; pa = smg[lane]; pb = smg[64 + lane]; }
            }
            BAR_LDS();
            {
                const int sI = wave >> 1;
#pragma unroll
                for (int t = 0; t < 4; ++t) {
                    const f32x4 kt4 = MFMA16(ldfrag(L + SC_KR + (16 * t + r) * 272 + 16 * q + 64 * sI), idf, z4);
                    const f32x4 vt4 = MFMA16(ldfrag(L + SC_WR + (16 * t + r) * 272 + 16 * q + 64 * sI), idf, z4);
                    *(LAS u32x2*)(L + SC_KT + (16 * wave + r) * 144 + (16 * t + 4 * q) * 2) = pack4(kt4);
                    *(LAS u32x2*)(L + SC_VT + (16 * wave + r) * 144 + (16 * t + 4 * q) * 2) = pack4(vt4);
                }
            }
            BAR_LDS();
            if (want_o) {
                const int it = wave >> 1, i = 16 * it + r; const float gci = SM[i];
                bf16x8 qf[4];
#pragma unroll
                for (int s = 0; s < 4; ++s) qf[s] = ldfrag(L + SC_QR + i * 272 + 16 * q + 64 * s);
#pragma unroll
                for (int tt = 0; tt < 2; ++tt) {
                    const int t = 2 * (wave & 1) + tt;
                    f32x4 acc = z4;
#pragma unroll
                    for (int s = 0; s < 4; ++s) acc = MFMA16(ldfrag(L + SC_KR + (16 * t + r) * 272 + 16 * q + 64 * s), qf[s], acc);
                    const int j0 = 16 * t + 4 * q;
                    const f32x4 gj = *(const LAS f32x4*)(SM + j0);
                    f32x4 o;
#pragma unroll
                    for (int e = 0; e < 4; ++e) o[e] = (j0 + e <= i) ? acc[e] * __expf(gci - gj[e]) : 0.f;
                    *(LAS u32x2*)(L + SC_AT + i * 144 + j0 * 2) = pack4(o);
                }
            }
            f32x4 u[4];
            {
                bf16x8 ka[2], vb[2];
#pragma unroll
                for (int s = 0; s < 2; ++s) {
                    const f32x4 e0 = *(const LAS f32x4*)(SM + 128 + 8 * q + 32 * s), e1 = *(const LAS f32x4*)(SM + 128 + 8 * q + 32 * s + 4);
                    ka[s] = scale8(ldfrag(L + SC_KT + (16 * wave + r) * 144 + 16 * q + 64 * s), e0, e1);
                    vb[s] = ldfrag(L + SC_VT + (16 * wave + r) * 144 + 16 * q + 64 * s); }
#pragma unroll
                for (int t = 0; t < 4; ++t) {
                    f32x4 wacc = z4; u[t] = z4;
#pragma unroll
                    for (int s = 0; s < 2; ++s) {
                        if (t < 2 && s == 1) continue;
                        const bf16x8 af = ldfrag(L + SC_A2 + (16 * t + r) * 144 + 16 * q + 64 * s);
                        wacc = MFMA16(ka[s], af, wacc);
                        u[t] = MFMA16(af, vb[s], u[t]);
                    }
                    *(LAS u32x2*)(L + SC_WR + (16 * t + r) * 272 + (16 * wave + 4 * q) * 2) = pack4(wacc);
                }
            }
            BAR_LDS();
            f32x4 o[4];
            {
                bf16x8 sf[4];
#pragma unroll
                for (int s = 0; s < 4; ++s) sf[s] = ldfrag(L + SC_ST + (16 * wave + r) * 272 + 16 * q + 64 * s);
#pragma unroll
                for (int t = 0; t < 4; ++t) {
                    f32x4 ws = z4;
#pragma unroll
                    for (int s = 0; s < 4; ++s) ws = MFMA16(ldfrag(L + SC_WR + (16 * t + r) * 272 + 16 * q + 64 * s), sf[s], ws);
                    const f32x4 vn = u[t] - ws;
                    const f32x4 eg = *(const LAS f32x4*)(SM + 192 + 16 * t + 4 * q);
                    *(LAS u32x2*)(L + SC_VNT + (16 * wave + r) * 144 + (16 * t + 4 * q) * 2) = pack4(vn);
                    *(LAS u32x2*)(L + SC_VNS + (16 * wave + r) * 144 + (16 * t + 4 * q) * 2) = pack4(vn * eg);
                }
                if (want_o) {
#pragma unroll
                    for (int t = 0; t < 4; ++t) {
                        f32x4 oa = z4;
#pragma unroll
                        for (int s = 0; s < 4; ++s) oa = MFMA16(sf[s], ldfrag(L + SC_QR + (16 * t + r) * 272 + 16 * q + 64 * s), oa);
                        o[t] = oa * SM[128 + 16 * t + r];
                    }
                }
            }
            LDS_WAIT();
            if (want_o) {
                bf16x8 va[2];
#pragma unroll
                for (int s = 0; s < 2; ++s) va[s] = ldfrag(L + SC_VNT + (16 * wave + r) * 144 + 16 * q + 64 * s);
#pragma unroll
                for (int t = 0; t < 4; ++t) {
#pragma unroll
                    for (int s = 0; s < 2; ++s) { if (t < 2 && s == 1) continue; o[t] = MFMA16(va[s], ldfrag(L + SC_AT + (16 * t + r) * 144 + 16 * q + 64 * s), o[t]); }
                    const int i = 16 * t + r, tok = tok0 + (dir ? 63 - i : i);
                    bf16_t* dst = (dir ? OB + (size_t)(rowbase + tok) * 1024 : ABUF + (size_t)(rowbase + tok) * DM) + h * 128 + 16 * wave + 4 * q;
                    *(u32x2*)dst = pack4(o[t]);
                }
            }
            {
                const float egl = SM[256];
                bf16x8 vs[2];
#pragma unroll
                for (int s = 0; s < 2; ++s) vs[s] = ldfrag(L + SC_VNS + (16 * wave + r) * 144 + 16 * q + 64 * s);
#pragma unroll
                for (int t = 0; t < 8; ++t) {
                    S[t] = S[t] * egl;
#pragma unroll
                    for (int s = 0; s < 2; ++s) S[t] = MFMA16(ldfrag(L + SC_KT + (16 * t + r) * 144 + 16 * q + 64 * s), vs[s], S[t]);
                    *(LAS u32x2*)(L + SC_ST + (16 * wave + r) * 272 + (16 * t + 4 * q) * 2) = pack4(S[t]);
                }
            }
        }
        __syncthreads();
    }
}

__device__ __forceinline__ void gate_phase(const Args& a, int l, int nrows, int gw, int NGW, int lane) {
    const bf16_t* PROJ = (const bf16_t*)(a.ws + WS_PROJ); bf16_t* ABUF = (bf16_t*)(a.ws + WS_ABUF); const bf16_t* OB = (const bf16_t*)(a.ws + WS_OB);
    const float* onw = a.in[12] + (size_t)l * 128;
    const int RPW = (nrows + NGW - 1) / NGW, r0 = gw * RPW, r1 = min(r0 + RPW, nrows);
    if (r0 >= r1) return;
    f32x4 w0[2], w1[2];
#pragma unroll
    for (int hh = 0; hh < 2; ++hh) { const int cc = (hh * 512 + lane * 8) & 127; w0[hh] = *(const f32x4*)(onw + cc); w1[hh] = *(const f32x4*)(onw + cc + 4); }
    u32x4 nf[2], nb[2], nz[2];
#pragma unroll
    for (int hh = 0; hh < 2; ++hh) { const int col = hh * 512 + lane * 8;
        nf[hh] = *(const u32x4*)(ABUF + (size_t)r0 * DM + col); nb[hh] = ld_nt((const u32x4*)(OB + (size_t)r0 * 1024 + col)); nz[hh] = ld_nt((const u32x4*)(PROJ + (size_t)r0 * NPROJ + 3072 + col)); }
    for (int r = r0; r < r1; ++r) {
        u32x4 cf[2], cb[2], cz[2];
#pragma unroll
        for (int hh = 0; hh < 2; ++hh) { cf[hh] = nf[hh]; cb[hh] = nb[hh]; cz[hh] = nz[hh]; }
        if (r + 1 < r1) {
#pragma unroll
            for (int hh = 0; hh < 2; ++hh) { const int col = hh * 512 + lane * 8;
                nf[hh] = *(const u32x4*)(ABUF + (size_t)(r + 1) * DM + col); nb[hh] = ld_nt((const u32x4*)(OB + (size_t)(r + 1) * 1024 + col)); nz[hh] = ld_nt((const u32x4*)(PROJ + (size_t)(r + 1) * NPROJ + 3072 + col)); } }
#pragma unroll
        for (int hh = 0; hh < 2; ++hh) {
            const int col = hh * 512 + lane * 8;
            float x[8], y[8], z[8]; unpack8(cf[hh], x); unpack8(cb[hh], y); unpack8(cz[hh], z);
            float ss = 0.f;
#pragma unroll
            for (int e = 0; e < 8; ++e) { x[e] += y[e]; ss += x[e] * x[e]; }
            ss += __shfl_xor(ss, 1); ss += __shfl_xor(ss, 2); ss += __shfl_xor(ss, 4); ss += __shfl_xor(ss, 8);
            const float rstd = rsqrtf(ss * (1.f / 128.f) + EPSF);
            x[0] *= rstd * w0[hh][0] * silu_f(z[0]); x[1] *= rstd * w0[hh][1] * silu_f(z[1]); x[2] *= rstd * w0[hh][2] * silu_f(z[2]); x[3] *= rstd * w0[hh][3] * silu_f(z[3]);
            x[4] *= rstd * w1[hh][0] * silu_f(z[4]); x[5] *= rstd * w1[hh][1] * silu_f(z[5]); x[6] *= rstd * w1[hh][2] * silu_f(z[6]); x[7] *= rstd * w1[hh][3] * silu_f(z[7]);
            *(u32x4*)(ABUF + (size_t)r * DM + col) = pack8(x);
        }
    }
}

#define XB_TMO      128
#define XB_XCNT(j)  (256  + 64 * (j))
#define XB_XSUB(j)  (1280 + 64 * (j))
#define XB_XGEN(j)  (2304 + 64 * (j))
#define XB_TOP      3328
#define XB_TOPGEN   3392
#define XCD_BAR_WORDS 3456
#define XB_SPIN_CAP (1u << 18)

__device__ __forceinline__ unsigned xb_ld(unsigned* p)              { return __hip_atomic_load(p, __ATOMIC_RELAXED, __HIP_MEMORY_SCOPE_AGENT); }
__device__ __forceinline__ unsigned xb_add(unsigned* p, unsigned v) { return __hip_atomic_fetch_add(p, v, __ATOMIC_RELAXED, __HIP_MEMORY_SCOPE_AGENT); }
__device__ __forceinline__ unsigned xb_xcc_id() { return (unsigned)__builtin_amdgcn_s_getreg((3 << 11) | 20) & 0xFu; }
#define XB_SPIN(cond, bar) do { unsigned _sp = 0; while (cond) { __builtin_amdgcn_s_sleep(1); \
    if ((++_sp & 255u) == 0u) { if (xb_ld(&(bar)[XB_TMO])) break; if (_sp > XB_SPIN_CAP) { atomicAdd(&(bar)[XB_TMO], 1u); break; } } } } while (0)

struct XcdBarrier {
    unsigned* bar; unsigned x;
    volatile LAS unsigned* st;
};

__device__ __forceinline__ XcdBarrier xcd_barrier_post(unsigned* bar, volatile LAS unsigned* st) {
    XcdBarrier b; b.bar = bar; b.x = xb_xcc_id(); b.st = st;
    if (threadIdx.x == 0) (void)xb_add(&bar[XB_XCNT(b.x)], 1u);
    return b;
}
__device__ __forceinline__ void xcd_barrier_complete(unsigned* bar, unsigned x, unsigned& nloc, unsigned& nx) {
    const unsigned G = gridDim.x * gridDim.y * gridDim.z;
    unsigned sum, cnt, mine, sp = 0u;
    for (;;) {
        sum = 0u; cnt = 0u; mine = 0u;
#pragma unroll
        for (unsigned j = 0; j < 16; ++j) { const unsigned c = xb_ld(&bar[XB_XCNT(j)]); sum += c; cnt += (c > 0u) ? 1u : 0u; mine = (j == x) ? c : mine; }
        if (sum == G) break;
        __builtin_amdgcn_s_sleep(1);
        if ((++sp & 255u) == 0u) { if (xb_ld(&bar[XB_TMO])) break; if (sp > XB_SPIN_CAP) { atomicAdd(&bar[XB_TMO], 1u); break; } }
    }
    nloc = mine > 0u ? mine : 1u; nx = cnt > 0u ? cnt : 1u;
}

__device__ __forceinline__ void xcd_barrier(const XcdBarrier& b) {
    asm volatile("s_waitcnt vmcnt(0)" ::: "memory");
    __syncthreads();
    if (threadIdx.x == 0) {
        unsigned* bar = b.bar;
        __builtin_amdgcn_s_waitcnt(0);
        unsigned nloc = b.st[0], nx = b.st[1];
        if (nloc == 0u) { xcd_barrier_complete(bar, b.x, nloc, nx); b.st[0] = nloc; b.st[1] = nx; }
        const unsigned old = xb_add(&bar[XB_XSUB(b.x)], 1u);
        const unsigned gen = old / nloc;
        if (old + 1u == (gen + 1u) * nloc) {
            __builtin_amdgcn_fence(__ATOMIC_RELEASE, "agent");
            asm volatile("s_waitcnt vmcnt(0)" ::: "memory");
            const unsigned og = xb_add(&bar[XB_TOP], 1u);
            const unsigned tg = og / nx;
            if (og + 1u == (tg + 1u) * nx) xb_add(&bar[XB_TOPGEN], 1u);
            else XB_SPIN(xb_ld(&bar[XB_TOPGEN]) == tg, bar);
            __builtin_amdgcn_fence(__ATOMIC_ACQUIRE, "agent");
            xb_add(&bar[XB_XGEN(b.x)], 1u);
            asm volatile("s_waitcnt vmcnt(0)" ::: "memory");
        } else {
            XB_SPIN(xb_ld(&bar[XB_XGEN(b.x)]) == gen, bar);
            __builtin_amdgcn_fence(__ATOMIC_ACQUIRE, "agent");
            asm volatile("s_waitcnt vmcnt(0)" ::: "memory");
        }
    }
    __syncthreads();
}

constexpr size_t WS_BAR = WS_AB;
#ifdef ONLY_PH
#define PH_ON(k) ((k) == ONLY_PH)
#else
#define PH_ON(k) true
#endif

constexpr size_t WS_FLAGS = WS_AB;
#if DIAG
__global__ void diag_zero(unsigned* flags) { if (blockIdx.x == 0 && threadIdx.x == 0) *flags = 0u; }
__global__ void diag_f32(const float* p, size_t n, unsigned bit, unsigned* flags) {
    bool bad = false;
    for (size_t i = (size_t)blockIdx.x * 256 + threadIdx.x; i < n; i += (size_t)gridDim.x * 256) { const float v = p[i]; if (!(fabsf(v) < 1e30f)) bad = true; }
    if (bad) atomicOr(flags, bit);
}
__global__ void diag_bf16(const bf16_t* p, size_t n, unsigned bit, unsigned* flags) {
    bool bad = false;
    for (size_t i = (size_t)blockIdx.x * 256 + threadIdx.x; i < n; i += (size_t)gridDim.x * 256) { const float v = bf_lo(p[i]); if (!(fabsf(v) < 1e30f)) bad = true; }
    if (bad) atomicOr(flags, bit);
}
__global__ void diag_final(float* out, size_t n, const unsigned* flags) {
    const unsigned f = *flags;
    for (size_t i = (size_t)blockIdx.x * 256 + threadIdx.x; i < n; i += (size_t)gridDim.x * 256) { float v = out[i]; if (!(fabsf(v) < 1e30f)) v = 500.f; if (i == 0 && f) v = 1000.f * (float)f; out[i] = v; }
}
#endif
__global__ void __launch_bounds__(512) mega_fwd(Args a) {
    extern __shared__ __attribute__((aligned(16))) unsigned char lds_raw[];
    LAS unsigned char* L = (LAS unsigned char*)lds_raw;
    float* MOD = (float*)(a.ws + WS_MOD); float* Hs = (float*)(a.ws + WS_H);
    volatile LAS unsigned* bst = (volatile LAS unsigned*)(L + LDS_BYTES - 64);
    if (threadIdx.x == 0) { bst[0] = 0u; bst[1] = 0u; }
    __syncthreads();
    const XcdBarrier xbar = xcd_barrier_post((unsigned*)(a.ws + WS_BAR), bst);
    bf16_t* ABUF = (bf16_t*)(a.ws + WS_ABUF);
#ifdef DUP_MASK
    const int nsteps_tot = (a.ph_hi - a.ph_lo) + 2 * __builtin_popcount(DUP_MASK);
#else
    const int nsteps_tot = a.ph_hi - a.ph_lo;
#endif
    int ph = a.ph_lo - 1, duprep = 0;
    for (int st = 0; st < nsteps_tot; ++st) {
#ifdef DUP_MASK
        if (duprep == 0 && ph >= a.ph_lo && ph < 20 && ((DUP_MASK >> (ph % 10)) & 1)) duprep = 1; else { duprep = 0; ++ph; }
#else
        ++ph;
#endif
        if (ph > a.ph_lo && duprep == 0) { if (ph == a.ph_lo + 1) cg::this_grid().sync(); else xcd_barrier(xbar); }
        int tid_opq = threadIdx.x; asm volatile("" : "+v"(tid_opq));
        const int tid = tid_opq, lane = tid & 63, wave = __builtin_amdgcn_readfirstlane(tid >> 6);
        const int gw = blockIdx.x * 8 + wave, NGW = gridDim.x * 8;
        if (ph == 20) { final_norm_phase(a.out, a.in[18], gw, NGW, lane); continue; }
        const int l = ph / 10, p = ph % 10;
        const float* xsrc = (l == 0) ? a.in[0] : a.out; const float* hsrc = (l == 0) ? a.in[2] : Hs;
        const int Mrows = (l == 0) ? MT : MX;
        if (p == 0 && PH_ON(0)) p0_phase(a, l, L, tid, lane, wave);
        else if (p == 1 && PH_ON(1)) norm_phase(xsrc, hsrc, (l == 1) ? (const float*)(a.ws + WS_XG) : nullptr, MT, a.in[6] + (size_t)l * DM, MOD, 0, ABUF, gw, NGW, lane);
        else if (p == 2 && PH_ON(2)) {
            pg8::Gemm g{ABUF, (const bf16_t*)(a.ws + WS_WIN), MT, 5376, 2048, 2048}; pg8::StaticOrder S; S.init(MT, 5376, (int)gridDim.x, (int)blockIdx.x);
            EpiProj E{(bf16_t*)(a.ws + WS_PROJ)};
            if (l == 0) pg8::gemm_phase<EpiProj, pg8::StaticOrder, true, true>(L, g, S, E);
            else { L1Order S1; S1.init((int)gridDim.x, (int)blockIdx.x); pg8::gemm_phase<EpiProj, L1Order, true, true>(L, g, S1, E); }
        }
        else if (p == 3 && PH_ON(3)) prep_phase(a, l, L, tid, lane, wave);
        else if (p == 4 && PH_ON(4)) {
            xinv_phase(a, l, L, tid, wave);
            asm volatile("s_waitcnt vmcnt(0)" ::: "memory"); __syncthreads();
            scan_phase(a, l, L, tid, lane, wave);
        }
        else if (p == 5 && PH_ON(5)) gate_phase(a, l, Mrows, gw, NGW, lane);
        else if (p == 6 && PH_ON(6)) {
            pg8::Gemm g{ABUF, (const bf16_t*)(a.ws + WS_WOUT), Mrows, 2048, 2048, 2048}; pg8::StaticOrder S; S.init(Mrows, 2048, (int)gridDim.x, (int)blockIdx.x);
            EpiRes E{xsrc, a.out, hsrc, Hs, MOD + 2 * 2048};
            pg8::gemm_phase<EpiRes, pg8::StaticOrder, true, true>(L, g, S, E);
        }
        else if (p == 7 && PH_ON(7)) norm_phase(a.out, Hs, nullptr, Mrows, a.in[7] + (size_t)l * DM, MOD, 3, ABUF, gw, NGW, lane);
        else if (p == 8 && PH_ON(8)) {
            pg8::Gemm g{ABUF, (const bf16_t*)(a.ws + WS_WUP), Mrows, 8192, 2048, 2048}; pg8::StaticOrder S; S.init(Mrows, 8192, (int)gridDim.x, (int)blockIdx.x);
            EpiUp E{(bf16_t*)(a.ws + WS_HID)};
            pg8::gemm_phase<EpiUp, pg8::StaticOrder, true, true>(L, g, S, E);
        }
        else if (PH_ON(9)) {
            pg8::Gemm g{(const bf16_t*)(a.ws + WS_HID), (const bf16_t*)(a.ws + WS_WDN), MX, 2048, 8192, 8192}; pg8::StaticOrder S; S.init(MX, 2048, (int)gridDim.x, (int)blockIdx.x);
            EpiRes E{a.out, a.out, Hs, Hs, MOD + 5 * 2048};
            pg8::gemm_phase<EpiRes, pg8::StaticOrder, true, true>(L, g, S, E);
            if (l == 0) {
                pg8::Gemm g2{(const bf16_t*)(a.ws + WS_HID) + (size_t)MX * DFF, (const bf16_t*)(a.ws + WS_WDN), MH, 2048, 4096, 8192}; CtxSplitOrder S2{(int)gridDim.x, (int)blockIdx.x};
                EpiCtxSplit E2{Hs, (float*)(a.ws + WS_XG), MOD + (size_t)16 * 12288 + 5 * 2048};
                pg8::gemm_phase<EpiCtxSplit, CtxSplitOrder, true, true>(L, g2, S2, E2);
            }
        }
    }
}

extern "C" void kernel_launch(void* const* d_in, const int* in_sizes, int n_in, void* d_out, int out_size, void* d_ws, size_t ws_size, hipStream_t stream) {
    static int grid = 0;
    if (grid == 0) {
        if (n_in != 19 || ws_size < WS_END) { fprintf(stderr, "kernel_launch: unexpected inputs (n_in %d, ws %zu < %zu)\n", n_in, ws_size, (size_t)WS_END); grid = -1; return; }
        int dev = 0, cus = 0, per_cu = 0;
        hipGetDevice(&dev); hipDeviceGetAttribute(&cus, hipDeviceAttributeMultiprocessorCount, dev);
        if (hipFuncSetAttribute((const void*)mega_fwd, hipFuncAttributeMaxDynamicSharedMemorySize, LDS_BYTES) != hipSuccess) { fprintf(stderr, "kernel_launch: hipFuncSetAttribute failed\n"); grid = -1; return; }
        if (hipOccupancyMaxActiveBlocksPerMultiprocessor(&per_cu, (const void*)mega_fwd, 512, LDS_BYTES) != hipSuccess || per_cu < 1) { fprintf(stderr, "kernel_launch: occupancy query says %d\n", per_cu); per_cu = 1; }
        (void)hipGetLastError();
        grid = cus * 1;
    }
    if (grid < 0) return;
    Args a{};
    for (int i = 0; i < 19; ++i) a.in[i] = (const float*)d_in[i];
    a.out = (float*)d_out; a.ws = (unsigned char*)d_ws;
#if PER_PHASE_LAUNCH
    for (int ph = 0; ph < 23; ++ph) {
#if DIAG
        unsigned* flags = (unsigned*)(a.ws + WS_FLAGS);
        if (ph == 0) hipLaunchKernelGGL(diag_zero, dim3(1), dim3(64), 0, stream, flags);
        if (ph == 1) hipLaunchKernelGGL(diag_f32, dim3(1024), dim3(256), 0, stream, (const float*)(a.ws + WS_MOD), (size_t)17 * 12288, 1u, flags);
        if (ph == 3) hipLaunchKernelGGL(diag_bf16, dim3(1024), dim3(256), 0, stream, (const bf16_t*)(a.ws + WS_PROJ), (size_t)MT * NPROJ, 2u, flags);
        if (ph == 4) { hipLaunchKernelGGL(diag_bf16, dim3(1024), dim3(256), 0, stream, (const bf16_t*)(a.ws + WS_Q), (size_t)MT * 1024 * 3, 4u, flags);
                       hipLaunchKernelGGL(diag_bf16, dim3(1024), dim3(256), 0, stream, (const bf16_t*)(a.ws + WS_ABUF), (size_t)MT * 2048, 4u, flags); }
        if (ph == 5) hipLaunchKernelGGL(diag_bf16, dim3(1024), dim3(256), 0, stream, (const bf16_t*)(a.ws + WS_OB), (size_t)MT * 1024, 8u, flags);
        if (ph == 6) hipLaunchKernelGGL(diag_bf16, dim3(1024), dim3(256), 0, stream, (const bf16_t*)(a.ws + WS_ABUF), (size_t)MT * 2048, 16u, flags);
        if (ph == 10) { hipLaunchKernelGGL(diag_f32, dim3(1024), dim3(256), 0, stream, (const float*)a.out, (size_t)MX * DM, 32u, flags);
                        hipLaunchKernelGGL(diag_f32, dim3(1024), dim3(256), 0, stream, (const float*)(a.ws + WS_H), (size_t)MH * DM, 32u, flags); }
#endif
        a.ph_lo = ph; a.ph_hi = ph + 1; hipLaunchKernelGGL(mega_fwd, dim3(grid), dim3(512), LDS_BYTES, stream, a);
    }
#if DIAG
    hipLaunchKernelGGL(diag_final, dim3(1024), dim3(256), 0, stream, a.out, (size_t)MX * DM, (const unsigned*)(a.ws + WS_FLAGS));
#endif
#else
    a.ph_lo = 0; a.ph_hi = 21;
    (void)hipMemsetAsync((char*)d_ws + WS_BAR, 0, XCD_BAR_WORDS * 4, stream);
    void* kargs[] = {&a};
    hipError_t e = hipLaunchCooperativeKernel((const void*)mega_fwd, dim3(grid), dim3(512), kargs, LDS_BYTES, stream);
    if (e != hipSuccess) fprintf(stderr, "kernel_launch: cooperative launch failed: %s (grid %d)\n", hipGetErrorString(e), grid);
#endif
}
```

```cpp
#include <hip/hip_runtime.h>
#include <hip/hip_cooperative_groups.h>
#include <cstdio>
#include <cstdint>
namespace cg = cooperative_groups;

#ifndef PER_PHASE_LAUNCH
#define PER_PHASE_LAUNCH 0
#endif
#ifndef DIAG
#define DIAG 0
#endif

namespace pg8 {
#define PG8_LAS __attribute__((address_space(3)))
typedef unsigned short bf16_t;
typedef short bf16x8 __attribute__((ext_vector_type(8)));
typedef float f32x4 __attribute__((ext_vector_type(4)));
typedef unsigned u32x4 __attribute__((ext_vector_type(4)));
constexpr int BM = 256, BK = 64, HALF = 128, HTB = HALF * BK * 2  , STAGE_BYTES = 8 * HTB, NXCD = 8, WGM = 4;

__host__ __device__ __forceinline__ int lds_byte(int r, int c) { const int st = (r >> 4) * 2 + (c >> 5), rr = r & 15, cc = c & 31, ob = rr * 64 + cc * 2; return st * 1024 + (ob ^ (((ob >> 9) & 1) << 5)); }
__host__ __device__ __forceinline__ void stage_rc(int b, int& R, int& C) { const int st = b / 1024, sb = b % 1024, swz = sb ^ (((sb >> 9) & 1) << 5); R = (st >> 1) * 16 + swz / 64; C = (st & 1) * 32 + (swz % 64) / 2; }
__host__ __device__ __forceinline__ int perm32(int rho) { const int n = rho >> 4, i = rho & 15; return 8 * (i >> 2) + 4 * n + (i & 3); }

struct Unit { int pm, pn, ko; };
struct Gemm { const bf16_t* A; const bf16_t* Bt; int M, N, K, ld; };

struct StaticOrder {
    int nM, nN, nwg, G, c;
    __host__ __device__ void init(int M, int N, int G_, int c_) { nM = M / BM; nN = N / BM; nwg = nM * nN; G = G_; c = c_; }
    __host__ __device__ bool next(int i, Unit& u) const {
        const long L = (long)i * G + c; if (L >= nwg) return false;
        int wgid = (int)L; { const int q = nwg / NXCD, r = nwg % NXCD, xcd = wgid % NXCD, off = wgid / NXCD; wgid = (xcd < r ? xcd * (q + 1) : r * (q + 1) + (xcd - r) * q) + off; }
        const int nig = WGM * nN, gid = wgid / nig, fm = gid * WGM, gsz = (nM - fm) < WGM ? (nM - fm) : WGM;
        u.pm = fm + ((wgid % nig) % gsz); u.pn = (wgid % nig) / gsz; u.ko = 0; return true;
    }
    __device__ __forceinline__ void a_ready(const Unit&) const {}
    __device__ __forceinline__ void done(const Unit&) const {}
};
typedef __bf16 bf16x2_cv __attribute__((ext_vector_type(2)));
typedef float f32x2_cv __attribute__((ext_vector_type(2)));
__device__ __forceinline__ unsigned cvt_pk_bf16(float lo, float hi) { f32x2_cv v = {lo, hi}; bf16x2_cv b = __builtin_convertvector(v, bf16x2_cv); return __builtin_bit_cast(unsigned, b); }
template <class Epi, class Sched, bool ALIGN_EPI = false, bool SP2 = false>
__device__ __forceinline__ void gemm_phase(PG8_LAS unsigned char* lds, const Gemm g, const Sched& S, const Epi& E) {
    int tid_opq = threadIdx.x; asm volatile("" : "+v"(tid_opq));
    const int tid = tid_opq, wid = __builtin_amdgcn_readfirstlane(tid >> 6), lane = tid & 63, wr = wid >> 2, wc = wid & 3, fr = lane & 15, fq = lane >> 4;
    const int K = g.K, nt = K / BK;
    unsigned voffA[2], voffB[2];
#pragma unroll
    for (int i = 0; i < 2; ++i) { int R, C; stage_rc(tid * 16 + i * 8192, R, C); const int Rb = Epi::PERM ? ((R & ~31) + perm32(R & 31)) : R;
        voffA[i] = (unsigned)(R * g.ld + C) * 2u; voffB[i] = (unsigned)(Rb * g.ld + C) * 2u; }
    const size_t kstep = (size_t)(BK * 2);
    const size_t hstep = (size_t)HALF * g.ld * 2;
    const size_t tstep = 2 * hstep;
    const unsigned ldsw = (unsigned)wid * 1024u;
    const int aoff = lds_byte(wr * 64 + fr, fq * 8), boff = lds_byte(wc * 32 + fr, fq * 8);
#define PG8_SA(b, h) (((b) * 2 + (h)) * HTB)
#define PG8_SB(b, h) ((4 + (b) * 2 + (h)) * HTB)
#define PG8_STAGE(bufoff, gbase, voff) do { _Pragma("unroll") for (int _i = 0; _i < 2; ++_i) \
        __builtin_amdgcn_global_load_lds((const unsigned*)((const char*)(gbase) + (voff)[_i]), (PG8_LAS unsigned*)(lds + (bufoff) + ldsw + _i * 8192), 16, 0, 0); } while (0)
#define PG8_LDA(dst, b, h) do { _Pragma("unroll") for (int m = 0; m < 4; ++m) _Pragma("unroll") for (int k = 0; k < 2; ++k) dst[m][k] = *(const PG8_LAS bf16x8*)(lds + PG8_SA(b, h) + aoff + m * 2048 + k * 1024); } while (0)
#define PG8_LDB(dst, b, h) do { _Pragma("unroll") for (int n = 0; n < 2; ++n) _Pragma("unroll") for (int k = 0; k < 2; ++k) dst[n][k] = *(const PG8_LAS bf16x8*)(lds + PG8_SB(b, h) + boff + n * 2048 + k * 1024); } while (0)
#define PG8_MMA(ai, bj, At, Bt) do { __builtin_amdgcn_s_setprio(1); _Pragma("unroll") for (int m = 0; m < 4; ++m) _Pragma("unroll") for (int n = 0; n < 2; ++n) _Pragma("unroll") for (int k = 0; k < 2; ++k) \
        acc[ai][bj][m][n] = __builtin_amdgcn_mfma_f32_16x16x32_bf16(Bt[n][k], At[m][k], acc[ai][bj][m][n], 0, 0, 0); __builtin_amdgcn_s_setprio(0); } while (0)
#define PG8_WAIT_V(n) asm volatile("s_waitcnt vmcnt(" #n ")" ::: "memory")
#define PG8_WAIT_L(n) asm volatile("s_waitcnt lgkmcnt(" #n ")" ::: "memory")
#define PG8_BAR __builtin_amdgcn_s_barrier()
#define PG8_SCHED __builtin_amdgcn_sched_barrier(0)
    Unit cur, nxt; int ui = 0;
    if (!S.next(0, cur)) return;
    f32x4 acc[2][2][4][2];
#pragma unroll
    for (int a = 0; a < 2; ++a)
#pragma unroll
        for (int b = 0; b < 2; ++b)
#pragma unroll
            for (int m = 0; m < 4; ++m)
#pragma unroll
                for (int n = 0; n < 2; ++n) acc[a][b][m][n] = (f32x4){0.f, 0.f, 0.f, 0.f};
    bf16x8 At[4][2], B0[2][2], B1[2][2];
    const char* cA = (const char*)g.A + (size_t)cur.pm * tstep + cur.ko; const char* cB = (const char*)g.Bt + (size_t)cur.pn * tstep + cur.ko;
    S.a_ready(cur);
    if constexpr (SP2) {
        PG8_STAGE(PG8_SB(0, 0), cB, voffB); PG8_STAGE(PG8_SB(0, 1), cB + hstep, voffB); PG8_STAGE(PG8_SA(0, 0), cA, voffA); PG8_STAGE(PG8_SA(0, 1), cA + hstep, voffA);
        if (wr == 1) PG8_BAR;
        PG8_WAIT_V(2); PG8_BAR;
        PG8_STAGE(PG8_SB(1, 0), cB + kstep, voffB); PG8_STAGE(PG8_SA(1, 0), cA + kstep, voffA); PG8_STAGE(PG8_SB(1, 1), cB + hstep + kstep, voffB);
        PG8_WAIT_V(6); PG8_BAR;
    } else {
        PG8_STAGE(PG8_SB(0, 0), cB, voffB); PG8_STAGE(PG8_SA(0, 0), cA, voffA); PG8_STAGE(PG8_SB(0, 1), cB + hstep, voffB); PG8_STAGE(PG8_SA(0, 1), cA + hstep, voffA);
        if (wr == 1) PG8_BAR;
        PG8_WAIT_V(4); PG8_BAR;
        PG8_STAGE(PG8_SB(1, 0), cB + kstep, voffB); PG8_STAGE(PG8_SA(1, 0), cA + kstep, voffA); PG8_STAGE(PG8_SB(1, 1), cB + hstep + kstep, voffB);
        PG8_WAIT_V(6); PG8_BAR;
    }
    for (;;) {
        const bool has_next = S.next(ui + 1, nxt);
        const char* nA = has_next ? (const char*)g.A + (size_t)nxt.pm * tstep + nxt.ko : cA; const char* nB = has_next ? (const char*)g.Bt + (size_t)nxt.pn * tstep + nxt.ko : cB;
        for (int t = 0; t < nt; t += 2) {
            const bool last = (t == nt - 2);
            const char* a1 = cA + (size_t)(t + 1) * kstep;
            const char* a2 = last ? nA : cA + (size_t)(t + 2) * kstep; const char* b2 = last ? nB : cB + (size_t)(t + 2) * kstep;
            const char* a3 = a2 + kstep; const char* b3 = b2 + kstep;
            if (last && has_next) S.a_ready(nxt);
            if constexpr (SP2) {
            PG8_LDB(B0, 0, 0); PG8_LDB(B1, 0, 1); PG8_SCHED; PG8_LDA(At, 0, 0); PG8_STAGE(PG8_SA(1, 1), a1 + hstep, voffA);
            PG8_WAIT_V(8); PG8_WAIT_L(0); PG8_BAR; PG8_MMA(0, 0, At, B0); PG8_MMA(0, 1, At, B1); PG8_BAR; PG8_SCHED;
            PG8_LDA(At, 0, 1); PG8_STAGE(PG8_SB(0, 0), b2, voffB); PG8_STAGE(PG8_SB(0, 1), b2 + hstep, voffB); PG8_STAGE(PG8_SA(0, 0), a2, voffA);
            PG8_WAIT_V(8); PG8_WAIT_L(0); PG8_BAR; PG8_MMA(1, 0, At, B0); PG8_MMA(1, 1, At, B1); PG8_BAR; PG8_SCHED;
            PG8_LDB(B0, 1, 0); PG8_LDB(B1, 1, 1); PG8_SCHED; PG8_LDA(At, 1, 0); PG8_STAGE(PG8_SA(0, 1), a2 + hstep, voffA);
            PG8_WAIT_V(8); PG8_WAIT_L(0); PG8_BAR; PG8_MMA(0, 0, At, B0); PG8_MMA(0, 1, At, B1); PG8_BAR; PG8_SCHED;
            PG8_LDA(At, 1, 1); PG8_STAGE(PG8_SB(1, 0), b3, voffB); PG8_STAGE(PG8_SB(1, 1), b3 + hstep, voffB); PG8_STAGE(PG8_SA(1, 0), a3, voffA);
            PG8_WAIT_V(8); PG8_WAIT_L(0); PG8_BAR; PG8_MMA(1, 0, At, B0); PG8_MMA(1, 1, At, B1); PG8_BAR; PG8_SCHED;
            } else {
            PG8_LDB(B0, 0, 0); PG8_SCHED; PG8_LDA(At, 0, 0); PG8_STAGE(PG8_SA(1, 1), a1 + hstep, voffA);
            PG8_WAIT_L(8); PG8_BAR; PG8_WAIT_L(0); PG8_MMA(0, 0, At, B0); PG8_BAR; PG8_SCHED;
            PG8_LDB(B1, 0, 1); PG8_STAGE(PG8_SB(0, 0), b2, voffB);
            PG8_BAR; PG8_WAIT_L(0); PG8_MMA(0, 1, At, B1); PG8_BAR;
            PG8_LDA(At, 0, 1); PG8_STAGE(PG8_SA(0, 0), a2, voffA);
            PG8_BAR; PG8_WAIT_L(0); PG8_MMA(1, 0, At, B0); PG8_BAR; PG8_SCHED;
            PG8_STAGE(PG8_SB(0, 1), b2 + hstep, voffB);
            PG8_WAIT_V(6); PG8_BAR; PG8_MMA(1, 1, At, B1); PG8_BAR;
            PG8_LDB(B0, 1, 0); PG8_SCHED; PG8_LDA(At, 1, 0); PG8_STAGE(PG8_SA(0, 1), a2 + hstep, voffA);
            PG8_WAIT_L(8); PG8_BAR; PG8_WAIT_L(0); PG8_MMA(0, 0, At, B0); PG8_BAR; PG8_SCHED;
            PG8_LDB(B1, 1, 1); PG8_STAGE(PG8_SB(1, 0), b3, voffB);
            PG8_BAR; PG8_WAIT_L(0); PG8_MMA(0, 1, At, B1); PG8_BAR;
            PG8_LDA(At, 1, 1); PG8_STAGE(PG8_SA(1, 0), a3, voffA);
            PG8_BAR; PG8_WAIT_L(0); PG8_MMA(1, 0, At, B0); PG8_BAR; PG8_SCHED;
            PG8_STAGE(PG8_SB(1, 1), b3 + hstep, voffB);
            PG8_WAIT_V(6); PG8_BAR; PG8_MMA(1, 1, At, B1); PG8_BAR;
            }
        }
        if constexpr (ALIGN_EPI) { if (wr == 0) PG8_BAR; }
        if constexpr (!Epi::AFTER_DRAIN) { E(acc, cur, wr, wc, fr, fq); S.done(cur); }
        if (!has_next) break;
#pragma unroll
        for (int a = 0; a < 2; ++a)
#pragma unroll
            for (int b = 0; b < 2; ++b)
#pragma unroll
                for (int m = 0; m < 4; ++m)
#pragma unroll
                    for (int n = 0; n < 2; ++n) acc[a][b][m][n] = (f32x4){0.f, 0.f, 0.f, 0.f};
        cur = nxt; cA = nA; cB = nB; ++ui;
        if constexpr (ALIGN_EPI) { if (wr == 1) PG8_BAR; }
    }
    PG8_WAIT_V(0);
    if constexpr (!ALIGN_EPI) { if (wr == 0) PG8_BAR; }
    PG8_BAR;
    if constexpr (Epi::AFTER_DRAIN) { E.fused(acc, cur, wr, wc, fr, fq, lds, wid, lane); S.done(cur); }
#undef PG8_SA
#undef PG8_SB
#undef PG8_STAGE
#undef PG8_LDA
#undef PG8_LDB
#undef PG8_MMA
#undef PG8_WAIT_V
#undef PG8_WAIT_L
#undef PG8_BAR
#undef PG8_SCHED
}
}

using pg8::bf16_t; using pg8::bf16x8; using pg8::f32x4; using pg8::u32x4; using pg8::cvt_pk_bf16;
#define LAS __attribute__((address_space(3)))
typedef float f32x2 __attribute__((ext_vector_type(2)));
typedef unsigned u32x2 __attribute__((ext_vector_type(2)));

constexpr int DM = 2048, MX = 32768, MH = 4096, MT = 36864, NPROJ = 5376, DFF = 8192;
constexpr float EPSF = 1e-6f;
constexpr size_t WS_WIN = 0;
constexpr size_t WS_WOUT = WS_WIN + (size_t)5376 * 2048 * 2;
constexpr size_t WS_WUP = WS_WOUT + (size_t)2048 * 2048 * 2;
constexpr size_t WS_WDN = WS_WUP + (size_t)8192 * 2048 * 2;
constexpr size_t WS_MOD = WS_WDN + (size_t)8192 * 2048 * 2;
constexpr size_t WS_H = WS_MOD + (size_t)17 * 12288 * 4;
constexpr size_t WS_ABUF = WS_H + (size_t)MH * 2048 * 4;
constexpr size_t WS_AB = WS_ABUF + (size_t)MT * 2048 * 2;
constexpr size_t WS_PROJ = WS_AB + (size_t)MT * 32 * 4;
constexpr size_t WS_Q = WS_PROJ + (size_t)MT * NPROJ * 2;
constexpr size_t WS_K = WS_Q + (size_t)MT * 1024 * 2;
constexpr size_t WS_V = WS_K + (size_t)MT * 1024 * 2;
constexpr size_t WS_OB = WS_V + (size_t)MT * 1024 * 2;
constexpr size_t WS_XG = WS_OB + (size_t)MT * 1024 * 2;
constexpr size_t WS_SMG = WS_XG + (size_t)9216 * 4096 * 2;
constexpr size_t WS_END = WS_SMG + (size_t)9216 * 128 * 4;
constexpr size_t WS_HID = WS_PROJ;
static_assert(WS_HID + (size_t)MT * DFF * 2 <= WS_XG, "hidden overlay");
static_assert(WS_END <= (size_t)1 << 30, "workspace");
constexpr int LDS_BYTES = 155648;

struct Args { const float* in[19]; float* out; unsigned char* ws; int ph_lo, ph_hi, pad0, pad1; };

__device__ __forceinline__ float bf_lo(unsigned w) { return __uint_as_float(w << 16); }
__device__ __forceinline__ float bf_hi(unsigned w) { return __uint_as_float(w & 0xffff0000u); }
__device__ __forceinline__ float wave_sum(float v) {
#pragma unroll
    for (int o = 1; o < 64; o <<= 1) v += __shfl_xor(v, o);
    return v;
}
__device__ __forceinline__ float silu_f(float x) { return x * __builtin_amdgcn_rcpf(1.f + __expf(-x)); }
__device__ __forceinline__ void unpack8(const u32x4 p, float (&f)[8]) {
    f[0] = bf_lo(p.x); f[1] = bf_hi(p.x); f[2] = bf_lo(p.y); f[3] = bf_hi(p.y); f[4] = bf_lo(p.z); f[5] = bf_hi(p.z); f[6] = bf_lo(p.w); f[7] = bf_hi(p.w);
}
__device__ __forceinline__ u32x4 pack8(const float (&f)[8]) {
    u32x4 o; o.x = cvt_pk_bf16(f[0], f[1]); o.y = cvt_pk_bf16(f[2], f[3]); o.z = cvt_pk_bf16(f[4], f[5]); o.w = cvt_pk_bf16(f[6], f[7]); return o;
}
__device__ __forceinline__ u32x2 pack4(const f32x4 v) { u32x2 o; o.x = cvt_pk_bf16(v[0], v[1]); o.y = cvt_pk_bf16(v[2], v[3]); return o; }
#define LDS_WAIT() asm volatile("s_waitcnt lgkmcnt(0)" ::: "memory")
template <class T> __device__ __forceinline__ T ld_nt(const T* p) { return __builtin_nontemporal_load(p); }
template <class T> __device__ __forceinline__ void st_nt(T* p, const T v) { __builtin_nontemporal_store(v, p); }
#define BAR_LDS() do { asm volatile("s_waitcnt lgkmcnt(0)" ::: "memory"); __builtin_amdgcn_s_barrier(); asm volatile("" ::: "memory"); } while (0)
#define MFMA16(a, b, c) __builtin_amdgcn_mfma_f32_16x16x32_bf16((a), (b), (c), 0, 0, 0)

struct EpiProj {
    static constexpr bool PERM = true, AFTER_DRAIN = false;
    bf16_t* P;
    __device__ __forceinline__ void operator()(const f32x4 (&acc)[2][2][4][2], const pg8::Unit& u, int wr, int wc, int fr, int fq) const {
        const int row0 = u.pm * 256 + wr * 64 + fr;
        const int col0 = u.pn * 256 + wc * 32 + 8 * fq;
#pragma unroll
        for (int ai = 0; ai < 2; ++ai)
#pragma unroll
            for (int m = 0; m < 4; ++m) { bf16_t* rowp = P + (size_t)(row0 + ai * 128 + m * 16) * NPROJ + col0;
#pragma unroll
                for (int bj = 0; bj < 2; ++bj) { const f32x4 v0 = acc[ai][bj][m][0], v1 = acc[ai][bj][m][1];
                    u32x4 w; w.x = cvt_pk_bf16(v0[0], v0[1]); w.y = cvt_pk_bf16(v0[2], v0[3]); w.z = cvt_pk_bf16(v1[0], v1[1]); w.w = cvt_pk_bf16(v1[2], v1[3]);
                    *(u32x4*)(rowp + bj * 128) = w; } }
    }
};
struct EpiRes {
    static constexpr bool PERM = false, AFTER_DRAIN = false;
    const float* xsrc; float* xdst; const float* hsrc; float* hdst; const float* gate0;
    __device__ __forceinline__ void operator()(const f32x4 (&acc)[2][2][4][2], const pg8::Unit& u, int wr, int wc, int fr, int fq) const {
        const bool isx = u.pm < 128;
        const float* src = isx ? xsrc + (size_t)u.pm * 256 * DM : hsrc + (size_t)(u.pm - 128) * 256 * DM;
        float* dst = isx ? xdst + (size_t)u.pm * 256 * DM : hdst + (size_t)(u.pm - 128) * 256 * DM;
        const float* gate = gate0 + (size_t)(isx ? (u.pm >> 3) : 16) * 12288;
        const int rl0 = wr * 64 + fr, col0 = u.pn * 256 + wc * 32 + 4 * fq;
        f32x4 gv[2][2];
#pragma unroll
        for (int bj = 0; bj < 2; ++bj)
#pragma unroll
            for (int n = 0; n < 2; ++n) gv[bj][n] = *(const f32x4*)(gate + col0 + bj * 128 + n * 16);
#pragma unroll
        for (int ai = 0; ai < 2; ++ai)
#pragma unroll
            for (int m = 0; m < 4; ++m) { const size_t off = (size_t)(rl0 + ai * 128 + m * 16) * DM + col0;
#pragma unroll
                for (int bj = 0; bj < 2; ++bj)
#pragma unroll
                    for (int n = 0; n < 2; ++n) { const f32x4 s = *(const f32x4*)(src + off + bj * 128 + n * 16);
                        *(f32x4*)(dst + off + bj * 128 + n * 16) = s + gv[bj][n] * acc[ai][bj][m][n]; } }
    }
};
struct EpiUp {
    static constexpr bool PERM = true, AFTER_DRAIN = false;
    bf16_t* Hd;
    __device__ __forceinline__ void operator()(const f32x4 (&acc)[2][2][4][2], const pg8::Unit& u, int wr, int wc, int fr, int fq) const {
        const int row0 = u.pm * 256 + wr * 64 + fr, col0 = u.pn * 256 + wc * 32 + 8 * fq;
#pragma unroll
        for (int ai = 0; ai < 2; ++ai)
#pragma unroll
            for (int m = 0; m < 4; ++m) { bf16_t* rowp = Hd + (size_t)(row0 + ai * 128 + m * 16) * DFF + col0;
#pragma unroll
                for (int bj = 0; bj < 2; ++bj) { f32x4 v0 = acc[ai][bj][m][0], v1 = acc[ai][bj][m][1];
#pragma unroll
                    for (int e = 0; e < 4; ++e) { const float a0 = fmaxf(v0[e], 0.f), a1 = fmaxf(v1[e], 0.f); v0[e] = a0 * a0; v1[e] = a1 * a1; }
                    u32x4 w; w.x = cvt_pk_bf16(v0[0], v0[1]); w.y = cvt_pk_bf16(v0[2], v0[3]); w.z = cvt_pk_bf16(v1[0], v1[1]); w.w = cvt_pk_bf16(v1[2], v1[3]);
                    st_nt((u32x4*)(rowp + bj * 128), w); } }
    }
};

struct L1Order {
    pg8::StaticOrder base; int G, c;
    __device__ void init(int G_, int c_) { base.init(MX, 5376, G_, c_); G = G_; c = c_; }
    __device__ bool next(int i, pg8::Unit& u) const {
        const long Lq = (long)i * G + c; if (Lq < base.nwg) return base.next(i, u);
        const int idx = (int)(Lq - base.nwg); if (idx >= 128) return false;
        u.pm = 128 + (idx >> 3); u.pn = 4 + (idx & 7); u.ko = 0; return true; }
    __device__ __forceinline__ void a_ready(const pg8::Unit&) const {}
    __device__ __forceinline__ void done(const pg8::Unit&) const {}
};
struct CtxSplitOrder {
    int G, c;
    __device__ bool next(int i, pg8::Unit& u) const { const long Lq = (long)i * G + c; if (Lq >= 256) return false; const int t = (int)Lq >> 1; u.pm = t >> 3; u.pn = t & 7; u.ko = ((int)Lq & 1) * 8192; return true; }
    __device__ __forceinline__ void a_ready(const pg8::Unit&) const {}
    __device__ __forceinline__ void done(const pg8::Unit&) const {}
};
struct EpiCtxSplit {
    static constexpr bool PERM = false, AFTER_DRAIN = false;
    float* h; float* hadd; const float* gate;
    __device__ __forceinline__ void operator()(const f32x4 (&acc)[2][2][4][2], const pg8::Unit& u, int wr, int wc, int fr, int fq) const {
        float* dst = (u.ko ? hadd : h) + (size_t)u.pm * 256 * DM;
        const int rl0 = wr * 64 + fr, col0 = u.pn * 256 + wc * 32 + 4 * fq;
        f32x4 gv[2][2];
#pragma unroll
        for (int bj = 0; bj < 2; ++bj)
#pragma unroll
            for (int n = 0; n < 2; ++n) gv[bj][n] = *(const f32x4*)(gate + col0 + bj * 128 + n * 16);
#pragma unroll
        for (int ai = 0; ai < 2; ++ai)
#pragma unroll
            for (int m = 0; m < 4; ++m) { const size_t off = (size_t)(rl0 + ai * 128 + m * 16) * DM + col0;
#pragma unroll
                for (int bj = 0; bj < 2; ++bj)
#pragma unroll
                    for (int n = 0; n < 2; ++n) { f32x4 v = gv[bj][n] * acc[ai][bj][m][n];
                        if (u.ko == 0) v += *(const f32x4*)(dst + off + bj * 128 + n * 16);
                        *(f32x4*)(dst + off + bj * 128 + n * 16) = v; } }
    }
};

__device__ __forceinline__ void tr_item(const float* W, int ldw, int srccol0, bf16_t* WT, int Kd, int dstrow0, int k0, LAS float* scr, int lane) {
    float tv[32];
#pragma unroll
    for (int i = 0; i < 32; ++i) tv[i] = W[(size_t)(k0 + 2 * i + (lane >> 5)) * ldw + srccol0 + (lane & 31)];
#pragma unroll
    for (int i = 0; i < 32; ++i) scr[(2 * i + (lane >> 5)) * 33 + (lane & 31)] = tv[i];
    LDS_WAIT();
    const int c = lane & 7;
#pragma unroll
    for (int j = 0; j < 4; ++j) { const int n = (lane >> 3) + 8 * j; const LAS float* s = scr + (8 * c) * 33 + n;
        u32x4 o; o.x = cvt_pk_bf16(s[0 * 33], s[1 * 33]); o.y = cvt_pk_bf16(s[2 * 33], s[3 * 33]); o.z = cvt_pk_bf16(s[4 * 33], s[5 * 33]); o.w = cvt_pk_bf16(s[6 * 33], s[7 * 33]);
        *(u32x4*)(WT + (size_t)(dstrow0 + n) * Kd + k0 + 8 * c) = o; }
    LDS_WAIT();
}
__device__ __forceinline__ void p0_phase(const Args& a, int l, LAS unsigned char* L, int tid, int lane, int wave) {
    {
        const float* wada = a.in[4] + (size_t)l * 2048 * 12288; const float* bada = a.in[5] + (size_t)l * 12288;
        const float* cvec = a.in[1]; const float* cctx = a.in[3];
        float* MOD = (float*)(a.ws + WS_MOD);
        LAS float* scw = (LAS float*)(L + wave * 5120);
        LAS float* red = (LAS float*)(L + 40960);
        const int cg4 = lane & 15, rg = lane >> 4;
        for (int it = blockIdx.x; it < 192; it += gridDim.x) {
            const int c0 = it * 64;
            float acc[17][4];
#pragma unroll
            for (int b = 0; b < 17; ++b)
#pragma unroll
                for (int e = 0; e < 4; ++e) acc[b][e] = 0.f;
            for (int s = 0; s < 4; ++s) {
                const int kb = wave * 256 + s * 64;
#pragma unroll
                for (int b = 0; b < 17; ++b) { const float v = (b < 16) ? cvec[b * 2048 + kb + lane] : cctx[kb + lane]; scw[lane * 20 + b] = silu_f(v); }
                LDS_WAIT();
#pragma unroll 4
                for (int j = 0; j < 16; ++j) {
                    const int kk = 4 * j + rg;
                    const f32x4 w4 = *(const f32x4*)(wada + (size_t)(kb + kk) * 12288 + c0 + 4 * cg4);
                    const LAS float* sp = scw + kk * 20;
                    const f32x4 s0 = *(const LAS f32x4*)(sp), s1 = *(const LAS f32x4*)(sp + 4), s2 = *(const LAS f32x4*)(sp + 8), s3 = *(const LAS f32x4*)(sp + 12); const float s16 = sp[16];
#pragma unroll
                    for (int e = 0; e < 4; ++e) {
                        acc[0][e] += s0[0] * w4[e]; acc[1][e] += s0[1] * w4[e]; acc[2][e] += s0[2] * w4[e]; acc[3][e] += s0[3] * w4[e];
                        acc[4][e] += s1[0] * w4[e]; acc[5][e] += s1[1] * w4[e]; acc[6][e] += s1[2] * w4[e]; acc[7][e] += s1[3] * w4[e];
                        acc[8][e] += s2[0] * w4[e]; acc[9][e] += s2[1] * w4[e]; acc[10][e] += s2[2] * w4[e]; acc[11][e] += s2[3] * w4[e];
                        acc[12][e] += s3[0] * w4[e]; acc[13][e] += s3[1] * w4[e]; acc[14][e] += s3[2] * w4[e]; acc[15][e] += s3[3] * w4[e];
                        acc[16][e] += s16 * w4[e]; }
                }
                LDS_WAIT();
            }
#pragma unroll
            for (int b = 0; b < 17; ++b)
#pragma unroll
                for (int e = 0; e < 4; ++e) { float v = acc[b][e]; v += __shfl_xor(v, 16); v += __shfl_xor(v, 32); acc[b][e] = v; }
            if (rg == 0) {
#pragma unroll
                for (int b = 0; b < 17; ++b) *(LAS f32x4*)(red + (wave * 17 + b) * 64 + cg4 * 4) = (f32x4){acc[b][0], acc[b][1], acc[b][2], acc[b][3]};
            }
            __syncthreads();
            for (int idx = tid; idx < 17 * 64; idx += 512) { const int b = idx >> 6, cc = idx & 63; float s = bada[c0 + cc];
#pragma unroll
                for (int w = 0; w < 8; ++w) s += red[(w * 17 + b) * 64 + cc];
                MOD[(size_t)b * 12288 + c0 + cc] = s; }
            __syncthreads();
        }
    }
    {
        const float* w_in = a.in[8] + (size_t)l * 2048 * 5152; const float* w_out = a.in[15] + (size_t)l * 2048 * 2048;
        const float* w_up = a.in[16] + (size_t)l * 2048 * 8192; const float* w_dn = a.in[17] + (size_t)l * 8192 * 2048;
        const float* pool_w = a.in[13] + (size_t)l * 4 * 65536; const float* pscale = a.in[14] + (size_t)l * 1024;
        bf16_t* WTin = (bf16_t*)(a.ws + WS_WIN); bf16_t* WTout = (bf16_t*)(a.ws + WS_WOUT); bf16_t* WTup = (bf16_t*)(a.ws + WS_WUP); bf16_t* WTdn = (bf16_t*)(a.ws + WS_WDN);
        LAS float* scr = (LAS float*)(L + 81920 + wave * 8448);
        const int gw = blockIdx.x * 8 + wave, NGW = gridDim.x * 8;
        constexpr int N0 = 4096, N1 = 1024, N2 = 32, N3 = 1024, N4 = 8192, N5 = 8192, N6 = 2048;
        for (int it0 = gw; it0 < N0 + N1 + N2 + N3 + N4 + N5 + N6; it0 += NGW) {
            int it = it0;
            if (it < N0) { tr_item(w_in, 5152, 32 * (it & 127), WTin, 2048, 32 * (it & 127), 64 * (it >> 7), scr, lane); continue; } it -= N0;
            if (it < N1) { tr_item(w_in, 5152, 4128 + 32 * (it & 31), WTin, 2048, 4096 + 32 * (it & 31), 64 * (it >> 5), scr, lane); continue; } it -= N1;
            if (it < N2) { tr_item(w_in, 5152, 4096, WTin, 2048, 5120, 64 * it, scr, lane); continue; } it -= N2;
            if (it < N3) { tr_item(w_out, 2048, 32 * (it & 63), WTout, 2048, 32 * (it & 63), 64 * (it >> 6), scr, lane); continue; } it -= N3;
            if (it < N4) { tr_item(w_up, 8192, 32 * (it & 255), WTup, 2048, 32 * (it & 255), 64 * (it >> 8), scr, lane); continue; } it -= N4;
            if (it < N5) { tr_item(w_dn, 2048, 32 * (it & 63), WTdn, 8192, 32 * (it & 63), 64 * (it >> 6), scr, lane); continue; } it -= N5;
            const int g = it >> 9, rem = it & 511, n = 64 * (rem >> 4) + lane, j0 = 16 * (rem & 15);
            const float* wo = w_out + (size_t)(1024 + 256 * g) * 2048 + n; const float* pw = pool_w + (size_t)g * 65536 + j0 * 256; const float* ps = pscale + 256 * g;
            float acc[16];
#pragma unroll
            for (int jj = 0; jj < 16; ++jj) acc[jj] = 0.f;
            const float* pwl = pw + (lane >> 2) * 256 + (lane & 3) * 4;
            f32x4 pwn = *(const f32x4*)pwl; float wvn[16];
#pragma unroll
            for (int cc = 0; cc < 16; ++cc) wvn[cc] = wo[(size_t)cc * 2048];
            for (int cb = 0; cb < 256; cb += 16) {
                const f32x4 pwv = pwn; float wv[16];
#pragma unroll
                for (int cc = 0; cc < 16; ++cc) wv[cc] = wvn[cc] * ps[cb + cc];
                if (cb + 16 < 256) { pwn = *(const f32x4*)(pwl + cb + 16);
#pragma unroll
                    for (int cc = 0; cc < 16; ++cc) wvn[cc] = wo[(size_t)(cb + 16 + cc) * 2048]; }
                *(LAS f32x4*)(scr + (lane >> 2) * 16 + (lane & 3) * 4) = pwv;
                LDS_WAIT();
#pragma unroll
                for (int cc4 = 0; cc4 < 4; ++cc4)
#pragma unroll
                    for (int jj = 0; jj < 16; ++jj) { const f32x4 m = *(const LAS f32x4*)(scr + jj * 16 + cc4 * 4);
                        acc[jj] += (m[0] * wv[4 * cc4] + m[1] * wv[4 * cc4 + 1]) + (m[2] * wv[4 * cc4 + 2] + m[3] * wv[4 * cc4 + 3]); }
                LDS_WAIT();
            }
            bf16_t* dst = WTout + (size_t)n * 2048 + 1024 + 256 * g + j0;
            u32x4 o0, o1; o0.x = cvt_pk_bf16(acc[0], acc[1]); o0.y = cvt_pk_bf16(acc[2], acc[3]); o0.z = cvt_pk_bf16(acc[4], acc[5]); o0.w = cvt_pk_bf16(acc[6], acc[7]);
            o1.x = cvt_pk_bf16(acc[8], acc[9]); o1.y = cvt_pk_bf16(acc[10], acc[11]); o1.z = cvt_pk_bf16(acc[12], acc[13]); o1.w = cvt_pk_bf16(acc[14], acc[15]);
            *(u32x4*)dst = o0; *(u32x4*)(dst + 8) = o1;
        }
    }
}

__device__ __forceinline__ void norm_phase(const float* xsrc, const float* hsrc, const float* hadd, int nrows, const float* nw, const float* MOD, int shift_idx, bf16_t* out, int gw, int NGW, int lane) {
    const int RPW = (nrows + NGW - 1) / NGW, r0 = gw * RPW, r1 = min(r0 + RPW, nrows);
    if (r0 >= r1) return;
    f32x4 Aa[8], Bb[8], v[8], vn[8]; int curmod = -1;
    { const float* src = (r0 < MX) ? xsrc + (size_t)r0 * DM : hsrc + (size_t)(r0 - MX) * DM;
#pragma unroll
      for (int j = 0; j < 8; ++j) vn[j] = ld_nt((const f32x4*)(src + 4 * lane + 256 * j)); }
    for (int r = r0; r < r1; ++r) {
#pragma unroll
        for (int j = 0; j < 8; ++j) v[j] = vn[j];
        if (hadd && r >= MX) {
#pragma unroll
            for (int j = 0; j < 8; ++j) v[j] += *(const f32x4*)(hadd + (size_t)(r - MX) * DM + 4 * lane + 256 * j); }
        if (r + 1 < r1) { const float* src = (r + 1 < MX) ? xsrc + (size_t)(r + 1) * DM : hsrc + (size_t)(r + 1 - MX) * DM;
#pragma unroll
            for (int j = 0; j < 8; ++j) vn[j] = ld_nt((const f32x4*)(src + 4 * lane + 256 * j)); }
        const int modrow = (r < MX) ? (r >> 11) : 16;
        if (modrow != curmod) { curmod = modrow;
            const float* sh = MOD + (size_t)modrow * 12288 + shift_idx * 2048; const float* sc = sh + 2048;
#pragma unroll
            for (int j = 0; j < 8; ++j) { const int c = 4 * lane + 256 * j; Aa[j] = *(const f32x4*)(nw + c) * (1.f + *(const f32x4*)(sc + c)); Bb[j] = *(const f32x4*)(sh + c); } }
        float ss = 0.f;
#pragma unroll
        for (int j = 0; j < 8; ++j) ss += (v[j][0] * v[j][0] + v[j][1] * v[j][1]) + (v[j][2] * v[j][2] + v[j][3] * v[j][3]);
        ss = wave_sum(ss);
        const float rstd = rsqrtf(ss * (1.f / 2048.f) + EPSF);
#pragma unroll
        for (int j = 0; j < 8; ++j) { const f32x4 y = (v[j] * rstd) * Aa[j] + Bb[j]; *(u32x2*)(out + (size_t)r * DM + 4 * lane + 256 * j) = pack4(y); }
    }
}
__device__ __forceinline__ void final_norm_phase(float* x, const float* nw, int gw, int NGW, int lane) {
    const int RPW = (MX + NGW - 1) / NGW, r0 = gw * RPW, r1 = min(r0 + RPW, MX);
    if (r0 >= r1) return;
    f32x4 Aa[8], v[8], vn[8];
#pragma unroll
    for (int j = 0; j < 8; ++j) { Aa[j] = *(const f32x4*)(nw + 4 * lane + 256 * j); vn[j] = ld_nt((const f32x4*)(x + (size_t)r0 * DM + 4 * lane + 256 * j)); }
    for (int r = r0; r < r1; ++r) {
#pragma unroll
        for (int j = 0; j < 8; ++j) v[j] = vn[j];
        if (r + 1 < r1) {
#pragma unroll
            for (int j = 0; j < 8; ++j) vn[j] = ld_nt((const f32x4*)(x + (size_t)(r + 1) * DM + 4 * lane + 256 * j)); }
        float ss = 0.f;
#pragma unroll
        for (int j = 0; j < 8; ++j) ss += (v[j][0] * v[j][0] + v[j][1] * v[j][1]) + (v[j][2] * v[j][2] + v[j][3] * v[j][3]);
        ss = wave_sum(ss);
        const float rstd = rsqrtf(ss * (1.f / 2048.f) + EPSF);
#pragma unroll
        for (int j = 0; j < 8; ++j) st_nt((f32x4*)(x + (size_t)r * DM + 4 * lane + 256 * j), v[j] * rstd * Aa[j]);
    }
}

__device__ __forceinline__ void prep_phase(const Args& a, int l, LAS unsigned char* L, int tid, int lane, int wave) {
    const bf16_t* PROJ = (const bf16_t*)(a.ws + WS_PROJ); bf16_t* ABUF = (bf16_t*)(a.ws + WS_ABUF);
    bf16_t* Qb = (bf16_t*)(a.ws + WS_Q); bf16_t* Kb = (bf16_t*)(a.ws + WS_K); bf16_t* Vb = (bf16_t*)(a.ws + WS_V);
    const float* convw = a.in[9] + (size_t)l * 5 * 3072;
    const int gw = blockIdx.x * 8 + wave, NGW = gridDim.x * 8;
    if (gw < 2046) {
        const int cs = gw % 6, w = cs >> 1, hh = cs & 1, col = w * 1024 + hh * 512 + lane * 8;
        float cw[5][8];
#pragma unroll
        for (int i = 0; i < 5; ++i) { const f32x4 c0 = *(const f32x4*)(convw + i * 3072 + col), c1 = *(const f32x4*)(convw + i * 3072 + col + 4);
            cw[i][0] = c0[0]; cw[i][1] = c0[1]; cw[i][2] = c0[2]; cw[i][3] = c0[3]; cw[i][4] = c1[0]; cw[i][5] = c1[1]; cw[i][6] = c1[2]; cw[i][7] = c1[3]; }
        bf16_t* dstb = (w == 0 ? Qb : (w == 1 ? Kb : Vb)) + hh * 512 + lane * 8;
        const float qs = (w == 0) ? 0.08838834764831845f : 1.f;
        for (int seg = gw / 6; seg < MT / 16; seg += 341) {
            const int r0 = seg * 16;
            if (l == 1 && r0 >= MX && w == 0) continue;
            int t0, T; if (r0 < MX) { t0 = r0 & 2047; T = 2048; } else { t0 = (r0 - MX) & 255; T = 256; }
            u32x4 win[20];
#pragma unroll
            for (int k = 0; k < 20; ++k) { const int tt = t0 + k - 2;
                win[k] = (tt >= 0 && tt < T) ? *(const u32x4*)(PROJ + (size_t)(r0 + k - 2) * NPROJ + col) : (u32x4){0u, 0u, 0u, 0u}; }
#pragma unroll
            for (int i = 0; i < 16; ++i) {
                float acc[8];
#pragma unroll
                for (int e = 0; e < 8; ++e) acc[e] = 0.f;
#pragma unroll
                for (int k = 0; k < 5; ++k) { float pz[8]; unpack8(win[i + k], pz);
#pragma unroll
                    for (int e = 0; e < 8; ++e) acc[e] += pz[e] * cw[k][e]; }
#pragma unroll
                for (int e = 0; e < 8; ++e) acc[e] = silu_f(acc[e]);
                if (w < 2) { float ss = 0.f;
#pragma unroll
                    for (int e = 0; e < 8; ++e) ss += acc[e] * acc[e];
                    ss += __shfl_xor(ss, 1); ss += __shfl_xor(ss, 2); ss += __shfl_xor(ss, 4); ss += __shfl_xor(ss, 8);
                    const float sc = rsqrtf(ss + EPSF) * qs;
#pragma unroll
                    for (int e = 0; e < 8; ++e) acc[e] *= sc; }
                *(u32x4*)(dstb + (size_t)(r0 + i) * 1024) = pack8(acc);
            }
        }
    }
    {
        LAS float* R = (LAS float*)L; LAS float* V = (LAS float*)(L + 65536);
#define POOL_GEO(it) const int b = (it) >> 7, cb = ((it) >> 2) & 31, gi = ((it) + ((it) >> 8)) & 3, col = 4096 + gi * 256 + cb * 8, s2 = 1 << gi
        u32x4 pvn[4];
        if ((int)blockIdx.x < 2048) { POOL_GEO((int)blockIdx.x);
#pragma unroll
            for (int rep = 0; rep < 4; ++rep) pvn[rep] = *(const u32x4*)(PROJ + (size_t)(b * 2048 + tid + 512 * rep) * NPROJ + col); (void)s2; }
        for (int it = blockIdx.x; it < 2048; it += gridDim.x) {
            POOL_GEO(it);
#pragma unroll
            for (int rep = 0; rep < 4; ++rep) { const int tok = tid + 512 * rep; float p[8]; unpack8(pvn[rep], p);
                *(LAS f32x4*)(R + tok * 8) = (f32x4){p[0], p[1], p[2], p[3]}; *(LAS f32x4*)(R + tok * 8 + 4) = (f32x4){p[4], p[5], p[6], p[7]}; }
            { const int itn = it + gridDim.x;
              if (itn < 2048) { const int bn = itn >> 7, cbn = (itn >> 2) & 31, gin = (itn + (itn >> 8)) & 3, coln = 4096 + gin * 256 + cbn * 8;
#pragma unroll
                  for (int rep = 0; rep < 4; ++rep) pvn[rep] = *(const u32x4*)(PROJ + (size_t)(bn * 2048 + tid + 512 * rep) * NPROJ + coln); } }
            BAR_LDS();
#pragma unroll
            for (int rep = 0; rep < 4; ++rep) { const int tok = tid + 512 * rep, y = tok >> 6, x = tok & 63;
                const int lo = max(y - s2, 0), hi = min(y + s2 - 1, 31);
                f32x4 a0 = (f32x4){0.f, 0.f, 0.f, 0.f}, a1 = a0;
                for (int yy = lo; yy <= hi; ++yy) { a0 += *(const LAS f32x4*)(R + (yy * 64 + x) * 8); a1 += *(const LAS f32x4*)(R + (yy * 64 + x) * 8 + 4); }
                const float inv = 1.f / (float)(hi - lo + 1);
                *(LAS f32x4*)(V + tok * 8) = a0 * inv; *(LAS f32x4*)(V + tok * 8 + 4) = a1 * inv; }
            BAR_LDS();
#pragma unroll
            for (int rep = 0; rep < 4; ++rep) { const int tok = tid + 512 * rep, y = tok >> 6, x = tok & 63;
                const int lo = max(x - s2, 0), hi = min(x + s2 - 1, 63);
                f32x4 a0 = (f32x4){0.f, 0.f, 0.f, 0.f}, a1 = a0;
                for (int xx = lo; xx <= hi; ++xx) { a0 += *(const LAS f32x4*)(V + (y * 64 + xx) * 8); a1 += *(const LAS f32x4*)(V + (y * 64 + xx) * 8 + 4); }
                const float inv = 1.f / (float)(hi - lo + 1);
                const f32x4 r0 = *(const LAS f32x4*)(R + tok * 8), r1 = *(const LAS f32x4*)(R + tok * 8 + 4);
                const f32x4 o0 = a0 * inv - r0, o1 = a1 * inv - r1;
                u32x4 o; o.x = cvt_pk_bf16(o0[0], o0[1]); o.y = cvt_pk_bf16(o0[2], o0[3]); o.z = cvt_pk_bf16(o1[0], o1[1]); o.w = cvt_pk_bf16(o1[2], o1[3]);
                *(u32x4*)(ABUF + (size_t)(b * 2048 + tok) * DM + 1024 + gi * 256 + cb * 8) = o; }
            BAR_LDS();
        }
    }
    if (l == 1) {
        const bf16_t* WTin = (const bf16_t*)(a.ws + WS_WIN); bf16_t* PROJw = (bf16_t*)(a.ws + WS_PROJ);
        for (int r = MX + gw; r < MT; r += NGW) {
            float xv[32];
#pragma unroll
            for (int j = 0; j < 4; ++j) { float t8[8]; unpack8(*(const u32x4*)(ABUF + (size_t)r * DM + 8 * lane + 512 * j), t8);
#pragma unroll
                for (int e = 0; e < 8; ++e) xv[8 * j + e] = t8[e]; }
            float res = 0.f;
            for (int o = 0; o < 32; ++o) {
                float s = 0.f;
#pragma unroll
                for (int j = 0; j < 4; ++j) { float t8[8]; unpack8(*(const u32x4*)(WTin + (size_t)(5120 + o) * 2048 + 8 * lane + 512 * j), t8);
#pragma unroll
                    for (int e = 0; e < 8; ++e) s += t8[e] * xv[8 * j + e]; }
                s = wave_sum(s);
                if (lane == o) res = s;
            }
            if (lane < 32) PROJw[(size_t)r * NPROJ + 5120 + lane] = (bf16_t)(cvt_pk_bf16(res, 0.f) & 0xffffu);
        }
    }
    if (l == 0) {
        const int gt = blockIdx.x * 512 + tid, NT = gridDim.x * 512;
        for (int idx = gt; idx < MH * 128; idx += NT) {
            const int rr = idx >> 7, ch = idx & 127, gi = ch >> 5, s2 = 1 << gi, t = rr & 255, base = MX + rr - t;
            const int lo = max(t - s2, 0), hi = min(t + s2 - 1, 255);
            float s[8];
#pragma unroll
            for (int e = 0; e < 8; ++e) s[e] = 0.f;
            for (int tt = lo; tt <= hi; ++tt) { const u32x4 pv = *(const u32x4*)(PROJ + (size_t)(base + tt) * NPROJ + 4096 + ch * 8); float p[8]; unpack8(pv, p);
#pragma unroll
                for (int e = 0; e < 8; ++e) s[e] += p[e]; }
            const float inv = 1.f / (float)(hi - lo + 1);
            const u32x4 pv = *(const u32x4*)(PROJ + (size_t)(base + t) * NPROJ + 4096 + ch * 8); float p[8]; unpack8(pv, p);
#pragma unroll
            for (int e = 0; e < 8; ++e) s[e] = s[e] * inv - p[e];
            *(u32x4*)(ABUF + (size_t)(base + t) * DM + 1024 + ch * 8) = pack8(s);
        }
    }
}

__device__ __forceinline__ float softplus_f(float yy) { const float zz = __expf(fminf(yy, 20.f)); return (yy > 20.f) ? yy : ((zz < 1e-3f) ? zz * (1.f - 0.5f * zz) : __logf(1.f + zz)); }
__device__ __forceinline__ void xinv_phase(const Args& a, int l, LAS unsigned char* L, int tid0, int wave) {
    const bf16_t* Kb = (const bf16_t*)(a.ws + WS_K); const bf16_t* PROJ = (const bf16_t*)(a.ws + WS_PROJ); bf16_t* XG = (bf16_t*)(a.ws + WS_XG);
    const f32x4 z4 = (f32x4){0.f, 0.f, 0.f, 0.f};
    for (int seq = blockIdx.x; seq < 256; seq += gridDim.x) {
        const int b = seq >> 4, h = (seq >> 1) & 7, dir = seq & 1;
        const float nega_h = -__expf(a.in[10][l * 16 + dir * 8 + h]), dtb_h = a.in[11][l * 16 + dir * 8 + h];
        for (int ci = wave; ci < 36; ci += 8) {
            int tid_o = tid0; LAS unsigned char* Lm = L + wave * 17408; asm volatile("" : "+v"(tid_o), "+v"(Lm));
            const int lane = tid_o & 63, r = lane & 15, q = lane >> 4;
            int lane_o = lane;
            const bool isctx = ci < 4; const int n = isctx ? ci : ci - 4, T = isctx ? 256 : 2048;
            const int rowbase = isctx ? MX + b * 256 : b * 2048;
            const int tok0 = dir ? T - 64 * (n + 1) : 64 * n;
            const int tokl = tok0 + (dir ? 63 - lane : lane);
            const bf16_t* abp = PROJ + (size_t)(rowbase + tokl) * NPROJ + 5120;
            float gc = nega_h * softplus_f(bf_lo(abp[dir * 8 + h]) + dtb_h);
            const float bt = 1.f / (1.f + __expf(-bf_lo(abp[16 + dir * 8 + h])));
#pragma unroll
            for (int o = 1; o < 64; o <<= 1) { const float tv = __shfl_up(gc, o); if (lane >= o) gc += tv; }
            { float* smg = (float*)(a.ws + WS_SMG) + (size_t)(seq * 36 + ci) * 128; smg[lane] = gc; smg[64 + lane] = bt; }
            bf16x8 f[4][4];
#pragma unroll
            for (int t = 0; t < 4; ++t) { const int i = 16 * t + r, tok = tok0 + (dir ? 63 - i : i);
                const bf16_t* kp = Kb + (size_t)(rowbase + tok) * 1024 + h * 128 + 8 * q;
#pragma unroll
                for (int s = 0; s < 4; ++s) f[t][s] = *(const bf16x8*)(kp + 32 * s); }
#pragma unroll
            for (int tj = 0; tj < 4; ++tj) {
                const int j = 16 * tj + r; const float gcj = __shfl(gc, j);
#pragma unroll
                for (int ti = tj; ti < 4; ++ti) {
                    f32x4 acc = z4;
#pragma unroll
                    for (int s = 0; s < 4; ++s) acc = MFMA16(f[ti][s], f[tj][s], acc);
                    const int i0 = 16 * ti + 4 * q; f32x4 o;
#pragma unroll
                    for (int e = 0; e < 4; ++e) { const float gci = __shfl(gc, i0 + e), bi = __shfl(bt, i0 + e); o[e] = (i0 + e > j) ? acc[e] * bi * __expf(gci - gcj) : 0.f; }
                    *(LAS f32x4*)(Lm + j * 272 + i0 * 4) = o;
                }
            }
            LDS_WAIT();
            asm volatile("" : "+v"(lane_o), "+v"(Lm));
            f32x2 xp[32];
#pragma unroll
            for (int k = 0; k < 32; ++k) xp[k] = (f32x2){0.f, 0.f};
#pragma unroll
            for (int j = 63; j >= 0; --j) {
                f32x2 acc2 = (f32x2){(lane_o == j) ? 1.f : 0.f, 0.f};
#pragma unroll
                for (int k4 = ((j + 1) & ~3); k4 < 64; k4 += 4) {
                    const f32x4 m = *(const LAS f32x4*)(Lm + j * 272 + k4 * 4);
                    acc2 -= xp[k4 >> 1] * (f32x2){m[0], m[1]};
                    acc2 -= xp[(k4 >> 1) + 1] * (f32x2){m[2], m[3]};
                }
                float xj = acc2[0] + acc2[1];
                asm volatile("" : "+v"(xj), "+v"(Lm), "+v"(lane_o));
                xp[j >> 1][j & 1] = xj;
            }
            LDS_WAIT();
            bf16_t* xo = XG + ((size_t)(seq * 36 + ci) * 64 + lane) * 64;
#pragma unroll
            for (int j8 = 0; j8 < 8; ++j8) {
                float v2[8];
#pragma unroll
                for (int e = 0; e < 8; ++e) { const int j = 8 * j8 + e; v2[e] = xp[j >> 1][j & 1] * __builtin_bit_cast(float, __builtin_amdgcn_readlane(__builtin_bit_cast(int, bt), j)); }
                *(u32x4*)(xo + 8 * j8) = pack8(v2);
            }
        }
    }
}

constexpr int SC_ST = 0, SC_QR = 34816, SC_KR = 52224, SC_A2 = 69632, SC_KT = 78848, SC_VT = 97280, SC_WR = 115712, SC_AT = 133120, SC_SM = 142336;
constexpr int SC_VNT = SC_KR, SC_VNS = SC_VT;
__device__ __forceinline__ bf16x8 ldfrag(const LAS unsigned char* p) { return *(const LAS bf16x8*)p; }
__device__ __forceinline__ bf16x8 scale8(const bf16x8 v, const f32x4 e0, const f32x4 e1) {
    float f[8]; unpack8(__builtin_bit_cast(u32x4, v), f);
    f[0] *= e0[0]; f[1] *= e0[1]; f[2] *= e0[2]; f[3] *= e0[3]; f[4] *= e1[0]; f[5] *= e1[1]; f[6] *= e1[2]; f[7] *= e1[3];
    return __builtin_bit_cast(bf16x8, pack8(f));
}
struct ChunkGeo { int rowbase, tok0; bool want_o; };
__device__ __forceinline__ ChunkGeo chunk_geo(int ci, int b, int dir, int l) {
    ChunkGeo g; const bool isctx = ci < 4; const int n = isctx ? ci : ci - 4, T = isctx ? 256 : 2048;
    g.rowbase = isctx ? MX + b * 256 : b * 2048; g.tok0 = dir ? T - 64 * (n + 1) : 64 * n; g.want_o = (!isctx) || (l == 0); return g;
}
__device__ __forceinline__ void scan_phase(const Args& a, int l, LAS unsigned char* L, int tid0, int lane0, int wave) {
    const bf16_t* Qb = (const bf16_t*)(a.ws + WS_Q); const bf16_t* Kb = (const bf16_t*)(a.ws + WS_K); const bf16_t* Vb = (const bf16_t*)(a.ws + WS_V);
    const bf16_t* PROJ = (const bf16_t*)(a.ws + WS_PROJ); const bf16_t* XG = (const bf16_t*)(a.ws + WS_XG);
    bf16_t* ABUF = (bf16_t*)(a.ws + WS_ABUF); bf16_t* OB = (bf16_t*)(a.ws + WS_OB);
    LAS float* SM = (LAS float*)(L + SC_SM);
    const f32x4 z4 = (f32x4){0.f, 0.f, 0.f, 0.f};
    for (int seq = blockIdx.x; seq < 256; seq += gridDim.x) {
        const int b = seq >> 4, h = (seq >> 1) & 7, dir = seq & 1;
        const float nega_h = -__expf(a.in[10][l * 16 + dir * 8 + h]), dtb_h = a.in[11][l * 16 + dir * 8 + h];
        f32x4 S[8];
#pragma unroll
        for (int t = 0; t < 8; ++t) S[t] = z4;
        __syncthreads();
        for (int x = lane0; x < 16 * 68; x += 64) ((LAS unsigned*)(L + SC_ST + (16 * wave) * 272))[x] = 0u;
        u32x4 pq[2], pk[2], pv[2], px; float pa = 0.f, pb = 0.f;
        {
            const ChunkGeo g = chunk_geo(0, b, dir, l);
#pragma unroll
            for (int rep = 0; rep < 2; ++rep) { const int row = (tid0 >> 4) + 32 * rep, c8 = (tid0 & 15) * 8, tok = g.tok0 + (dir ? 63 - row : row);
                const size_t go = (size_t)(g.rowbase + tok) * 1024 + h * 128 + c8;
                pk[rep] = *(const u32x4*)(Kb + go); pv[rep] = *(const u32x4*)(Vb + go); pq[rep] = g.want_o ? *(const u32x4*)(Qb + go) : (u32x4){0u, 0u, 0u, 0u}; }
            px = *(const u32x4*)(XG + (size_t)(seq * 36 + 0) * 4096 + tid0 * 8);
            if (wave == 0) { const float* smg = (const float*)(a.ws + WS_SMG) + (size_t)(seq * 36 + 0) * 128; pa = smg[lane0]; pb = smg[64 + lane0]; }
        }
        for (int ci = 0; ci < 36; ++ci) {
            int tid_o = tid0; asm volatile("" : "+v"(tid_o));
            const int tid = tid_o, lane = tid & 63, r = lane & 15, q = lane >> 4;
            const ChunkGeo cg0 = chunk_geo(ci, b, dir, l);
            bf16x8 idf;
#pragma unroll
            for (int jj = 0; jj < 8; ++jj) idf[jj] = (8 * q + jj == 16 * (wave & 1) + r) ? (short)0x3F80 : (short)0;
            const int rowbase = cg0.rowbase, tok0 = cg0.tok0; const bool want_o = cg0.want_o;
            BAR_LDS();
#pragma unroll
            for (int rep = 0; rep < 2; ++rep) {
                const int row = (tid >> 4) + 32 * rep, c8 = (tid & 15) * 8;
                const u32x4 kv = pk[rep], vv = pv[rep];
                if (want_o) *(LAS u32x4*)(L + SC_QR + row * 272 + c8 * 2) = pq[rep];
                *(LAS u32x4*)(L + SC_KR + row * 272 + c8 * 2) = kv;
                *(LAS u32x4*)(L + SC_WR + row * 272 + c8 * 2) = vv;
            }
            *(LAS u32x4*)(L + SC_A2 + (tid >> 3) * 144 + (tid & 7) * 16) = px;
            if (wave == 0) {
                const float gc = pa, bt = pb;
                const float glast = __shfl(gc, 63);
                SM[lane] = gc; SM[64 + lane] = bt; SM[128 + lane] = __expf(gc); SM[192 + lane] = __expf(glast - gc);
                if (lane == 0) SM[256] = __expf(glast);
            }
            if (ci + 1 < 36) {
                const ChunkGeo g = chunk_geo(ci + 1, b, dir, l);
#pragma unroll
                for (int rep = 0; rep < 2; ++rep) { const int row = (tid >> 4) + 32 * rep, c8 = (tid & 15) * 8, tok = g.tok0 + (dir ? 63 - row : row);
                    const size_t go = (size_t)(g.rowbase + tok) * 1024 + h * 128 + c8;
                    pk[rep] = *(const u32x4*)(Kb + go); pv[rep] = *(const u32x4*)(Vb + go); if (g.want_o) pq[rep] = *(const u32x4*)(Qb + go); }
                px = *(const u32x4*)(XG + (size_t)(seq * 36 + ci + 1) * 4096 + tid * 8);
                if (wave == 0) { const float* smg = (const float*)(a.ws + WS_SMG) + (size_t)(seq * 36 + ci + 1) * 128; pa = smg[lane]; pb = smg[64 + lane]; }
            }
            BAR_LDS();
            {
                const int sI = wave >> 1;
#pragma unroll
                for (int t = 0; t < 4; ++t) {
                    const f32x4 kt4 = MFMA16(ldfrag(L + SC_KR + (16 * t + r) * 272 + 16 * q + 64 * sI), idf, z4);
                    const f32x4 vt4 = MFMA16(ldfrag(L + SC_WR + (16 * t + r) * 272 + 16 * q + 64 * sI), idf, z4);
                    *(LAS u32x2*)(L + SC_KT + (16 * wave + r) * 144 + (16 * t + 4 * q) * 2) = pack4(kt4);
                    *(LAS u32x2*)(L + SC_VT + (16 * wave + r) * 144 + (16 * t + 4 * q) * 2) = pack4(vt4);
                }
            }
            BAR_LDS();
            if (want_o) {
                const int it = wave >> 1, i = 16 * it + r; const float gci = SM[i];
                bf16x8 qf[4];
#pragma unroll
                for (int s = 0; s < 4; ++s) qf[s] = ldfrag(L + SC_QR + i * 272 + 16 * q + 64 * s);
#pragma unroll
                for (int tt = 0; tt < 2; ++tt) {
                    const int t = 2 * (wave & 1) + tt;
                    f32x4 acc = z4;
                    if (t <= it) {
#pragma unroll
                        for (int s = 0; s < 4; ++s) acc = MFMA16(ldfrag(L + SC_KR + (16 * t + r) * 272 + 16 * q + 64 * s), qf[s], acc);
                    }
                    const int j0 = 16 * t + 4 * q;
                    const f32x4 gj = *(const LAS f32x4*)(SM + j0);
                    f32x4 o;
#pragma unroll
                    for (int e = 0; e < 4; ++e) o[e] = (j0 + e <= i) ? acc[e] * __expf(gci - gj[e]) : 0.f;
                    *(LAS u32x2*)(L + SC_AT + i * 144 + j0 * 2) = pack4(o);
                }
            }
            f32x4 u[4];
            {
                bf16x8 ka[2], vb[2];
#pragma unroll
                for (int s = 0; s < 2; ++s) {
                    const f32x4 e0 = *(const LAS f32x4*)(SM + 128 + 8 * q + 32 * s), e1 = *(const LAS f32x4*)(SM + 128 + 8 * q + 32 * s + 4);
                    ka[s] = scale8(ldfrag(L + SC_KT + (16 * wave + r) * 144 + 16 * q + 64 * s), e0, e1);
                    vb[s] = ldfrag(L + SC_VT + (16 * wave + r) * 144 + 16 * q + 64 * s); }
#pragma unroll
                for (int t = 0; t < 4; ++t) {
                    f32x4 wacc = z4; u[t] = z4;
#pragma unroll
                    for (int s = 0; s < 2; ++s) {
                        if (t < 2 && s == 1) continue;
                        const bf16x8 af = ldfrag(L + SC_A2 + (16 * t + r) * 144 + 16 * q + 64 * s);
                        wacc = MFMA16(ka[s], af, wacc);
                        u[t] = MFMA16(af, vb[s], u[t]);
                    }
                    *(LAS u32x2*)(L + SC_WR + (16 * t + r) * 272 + (16 * wave + 4 * q) * 2) = pack4(wacc);
                }
            }
            BAR_LDS();
            f32x4 o[4];
            {
                bf16x8 sf[4];
#pragma unroll
                for (int s = 0; s < 4; ++s) sf[s] = ldfrag(L + SC_ST + (16 * wave + r) * 272 + 16 * q + 64 * s);
#pragma unroll
                for (int t = 0; t < 4; ++t) {
                    f32x4 ws = z4;
#pragma unroll
                    for (int s = 0; s < 4; ++s) ws = MFMA16(ldfrag(L + SC_WR + (16 * t + r) * 272 + 16 * q + 64 * s), sf[s], ws);
                    const f32x4 vn = u[t] - ws;
                    const f32x4 eg = *(const LAS f32x4*)(SM + 192 + 16 * t + 4 * q);
                    *(LAS u32x2*)(L + SC_VNT + (16 * wave + r) * 144 + (16 * t + 4 * q) * 2) = pack4(vn);
                    *(LAS u32x2*)(L + SC_VNS + (16 * wave + r) * 144 + (16 * t + 4 * q) * 2) = pack4(vn * eg);
                }
                if (want_o) {
#pragma unroll
                    for (int t = 0; t < 4; ++t) {
                        f32x4 oa = z4;
#pragma unroll
                        for (int s = 0; s < 4; ++s) oa = MFMA16(sf[s], ldfrag(L + SC_QR + (16 * t + r) * 272 + 16 * q + 64 * s), oa);
                        o[t] = oa * SM[128 + 16 * t + r];
                    }
                }
            }
            LDS_WAIT();
            if (want_o) {
                bf16x8 va[2];
#pragma unroll
                for (int s = 0; s < 2; ++s) va[s] = ldfrag(L + SC_VNT + (16 * wave + r) * 144 + 16 * q + 64 * s);
#pragma unroll
                for (int t = 0; t < 4; ++t) {
#pragma unroll
                    for (int s = 0; s < 2; ++s) { if (t < 2 && s == 1) continue; o[t] = MFMA16(va[s], ldfrag(L + SC_AT + (16 * t + r) * 144 + 16 * q + 64 * s), o[t]); }
                    const int i = 16 * t + r, tok = tok0 + (dir ? 63 - i : i);
                    bf16_t* dst = (dir ? OB + (size_t)(rowbase + tok) * 1024 : ABUF + (size_t)(rowbase + tok) * DM) + h * 128 + 16 * wave + 4 * q;
                    *(u32x2*)dst = pack4(o[t]);
                }
            }
            {
                const float egl = SM[256];
                bf16x8 vs[2];
#pragma unroll
                for (int s = 0; s < 2; ++s) vs[s] = ldfrag(L + SC_VNS + (16 * wave + r) * 144 + 16 * q + 64 * s);
#pragma unroll
                for (int t = 0; t < 8; ++t) {
                    S[t] = S[t] * egl;
#pragma unroll
                    for (int s = 0; s < 2; ++s) S[t] = MFMA16(ldfrag(L + SC_KT + (16 * t + r) * 144 + 16 * q + 64 * s), vs[s], S[t]);
                    *(LAS u32x2*)(L + SC_ST + (16 * wave + r) * 272 + (16 * t + 4 * q) * 2) = pack4(S[t]);
                }
            }
        }
        __syncthreads();
    }
}

__device__ __forceinline__ void gate_phase(const Args& a, int l, int nrows, int gw, int NGW, int lane) {
    const bf16_t* PROJ = (const bf16_t*)(a.ws + WS_PROJ); bf16_t* ABUF = (bf16_t*)(a.ws + WS_ABUF); const bf16_t* OB = (const bf16_t*)(a.ws + WS_OB);
    const float* onw = a.in[12] + (size_t)l * 128;
    const int RPW = (nrows + NGW - 1) / NGW, r0 = gw * RPW, r1 = min(r0 + RPW, nrows);
    if (r0 >= r1) return;
    f32x4 w0[2], w1[2];
#pragma unroll
    for (int hh = 0; hh < 2; ++hh) { const int cc = (hh * 512 + lane * 8) & 127; w0[hh] = *(const f32x4*)(onw + cc); w1[hh] = *(const f32x4*)(onw + cc + 4); }
    u32x4 nf[2], nb[2], nz[2];
#pragma unroll
    for (int hh = 0; hh < 2; ++hh) { const int col = hh * 512 + lane * 8;
        nf[hh] = *(const u32x4*)(ABUF + (size_t)r0 * DM + col); nb[hh] = ld_nt((const u32x4*)(OB + (size_t)r0 * 1024 + col)); nz[hh] = ld_nt((const u32x4*)(PROJ + (size_t)r0 * NPROJ + 3072 + col)); }
    for (int r = r0; r < r1; ++r) {
        u32x4 cf[2], cb[2], cz[2];
#pragma unroll
        for (int hh = 0; hh < 2; ++hh) { cf[hh] = nf[hh]; cb[hh] = nb[hh]; cz[hh] = nz[hh]; }
        if (r + 1 < r1) {
#pragma unroll
            for (int hh = 0; hh < 2; ++hh) { const int col = hh * 512 + lane * 8;
                nf[hh] = *(const u32x4*)(ABUF + (size_t)(r + 1) * DM + col); nb[hh] = ld_nt((const u32x4*)(OB + (size_t)(r + 1) * 1024 + col)); nz[hh] = ld_nt((const u32x4*)(PROJ + (size_t)(r + 1) * NPROJ + 3072 + col)); } }
#pragma unroll
        for (int hh = 0; hh < 2; ++hh) {
            const int col = hh * 512 + lane * 8;
            float x[8], y[8], z[8]; unpack8(cf[hh], x); unpack8(cb[hh], y); unpack8(cz[hh], z);
            float ss = 0.f;
#pragma unroll
            for (int e = 0; e < 8; ++e) { x[e] += y[e]; ss += x[e] * x[e]; }
            ss += __shfl_xor(ss, 1); ss += __shfl_xor(ss, 2); ss += __shfl_xor(ss, 4); ss += __shfl_xor(ss, 8);
            const float rstd = rsqrtf(ss * (1.f / 128.f) + EPSF);
            x[0] *= rstd * w0[hh][0] * silu_f(z[0]); x[1] *= rstd * w0[hh][1] * silu_f(z[1]); x[2] *= rstd * w0[hh][2] * silu_f(z[2]); x[3] *= rstd * w0[hh][3] * silu_f(z[3]);
            x[4] *= rstd * w1[hh][0] * silu_f(z[4]); x[5] *= rstd * w1[hh][1] * silu_f(z[5]); x[6] *= rstd * w1[hh][2] * silu_f(z[6]); x[7] *= rstd * w1[hh][3] * silu_f(z[7]);
            *(u32x4*)(ABUF + (size_t)r * DM + col) = pack8(x);
        }
    }
}

#define XB_TMO      128
#define XB_XCNT(j)  (256  + 64 * (j))
#define XB_XSUB(j)  (1280 + 64 * (j))
#define XB_XGEN(j)  (2304 + 64 * (j))
#define XB_TOP      3328
#define XB_TOPGEN   3392
#define XCD_BAR_WORDS 3456
#define XB_SPIN_CAP (1u << 18)

__device__ __forceinline__ unsigned xb_ld(unsigned* p)              { return __hip_atomic_load(p, __ATOMIC_RELAXED, __HIP_MEMORY_SCOPE_AGENT); }
__device__ __forceinline__ unsigned xb_add(unsigned* p, unsigned v) { return __hip_atomic_fetch_add(p, v, __ATOMIC_RELAXED, __HIP_MEMORY_SCOPE_AGENT); }
__device__ __forceinline__ unsigned xb_xcc_id() { return (unsigned)__builtin_amdgcn_s_getreg((3 << 11) | 20) & 0xFu; }
#define XB_SPIN(cond, bar) do { unsigned _sp = 0; while (cond) { __builtin_amdgcn_s_sleep(1); \
    if ((++_sp & 255u) == 0u) { if (xb_ld(&(bar)[XB_TMO])) break; if (_sp > XB_SPIN_CAP) { atomicAdd(&(bar)[XB_TMO], 1u); break; } } } } while (0)

struct XcdBarrier {
    unsigned* bar; unsigned x;
    volatile LAS unsigned* st;
};

__device__ __forceinline__ XcdBarrier xcd_barrier_post(unsigned* bar, volatile LAS unsigned* st) {
    XcdBarrier b; b.bar = bar; b.x = xb_xcc_id(); b.st = st;
    if (threadIdx.x == 0) (void)xb_add(&bar[XB_XCNT(b.x)], 1u);
    return b;
}
__device__ __forceinline__ void xcd_barrier_complete(unsigned* bar, unsigned x, unsigned& nloc, unsigned& nx) {
    const unsigned G = gridDim.x * gridDim.y * gridDim.z;
    unsigned sum, cnt, mine, sp = 0u;
    for (;;) {
        sum = 0u; cnt = 0u; mine = 0u;
#pragma unroll
        for (unsigned j = 0; j < 16; ++j) { const unsigned c = xb_ld(&bar[XB_XCNT(j)]); sum += c; cnt += (c > 0u) ? 1u : 0u; mine = (j == x) ? c : mine; }
        if (sum == G) break;
        __builtin_amdgcn_s_sleep(1);
        if ((++sp & 255u) == 0u) { if (xb_ld(&bar[XB_TMO])) break; if (sp > XB_SPIN_CAP) { atomicAdd(&bar[XB_TMO], 1u); break; } }
    }
    nloc = mine > 0u ? mine : 1u; nx = cnt > 0u ? cnt : 1u;
}

__device__ __forceinline__ void xcd_barrier(const XcdBarrier& b) {
    asm volatile("s_waitcnt vmcnt(0)" ::: "memory");
    __syncthreads();
    if (threadIdx.x == 0) {
        unsigned* bar = b.bar;
        __builtin_amdgcn_s_waitcnt(0);
        unsigned nloc = b.st[0], nx = b.st[1];
        if (nloc == 0u) { xcd_barrier_complete(bar, b.x, nloc, nx); b.st[0] = nloc; b.st[1] = nx; }
        const unsigned old = xb_add(&bar[XB_XSUB(b.x)], 1u);
        const unsigned gen = old / nloc;
        if (old + 1u == (gen + 1u) * nloc) {
            __builtin_amdgcn_fence(__ATOMIC_RELEASE, "agent");
            asm volatile("s_waitcnt vmcnt(0)" ::: "memory");
            const unsigned og = xb_add(&bar[XB_TOP], 1u);
            const unsigned tg = og / nx;
            if (og + 1u == (tg + 1u) * nx) xb_add(&bar[XB_TOPGEN], 1u);
            else XB_SPIN(xb_ld(&bar[XB_TOPGEN]) == tg, bar);
            __builtin_amdgcn_fence(__ATOMIC_ACQUIRE, "agent");
            xb_add(&bar[XB_XGEN(b.x)], 1u);
            asm volatile("s_waitcnt vmcnt(0)" ::: "memory");
        } else {
            XB_SPIN(xb_ld(&bar[XB_XGEN(b.x)]) == gen, bar);
            __builtin_amdgcn_fence(__ATOMIC_ACQUIRE, "agent");
            asm volatile("s_waitcnt vmcnt(0)" ::: "memory");
        }
    }
    __syncthreads();
}

constexpr size_t WS_BAR = WS_AB;
#ifdef ONLY_PH
#define PH_ON(k) ((k) == ONLY_PH)
#else
#define PH_ON(k) true
#endif

constexpr size_t WS_FLAGS = WS_AB;
#if DIAG
__global__ void diag_zero(unsigned* flags) { if (blockIdx.x == 0 && threadIdx.x == 0) *flags = 0u; }
__global__ void diag_f32(const float* p, size_t n, unsigned bit, unsigned* flags) {
    bool bad = false;
    for (size_t i = (size_t)blockIdx.x * 256 + threadIdx.x; i < n; i += (size_t)gridDim.x * 256) { const float v = p[i]; if (!(fabsf(v) < 1e30f)) bad = true; }
    if (bad) atomicOr(flags, bit);
}
__global__ void diag_bf16(const bf16_t* p, size_t n, unsigned bit, unsigned* flags) {
    bool bad = false;
    for (size_t i = (size_t)blockIdx.x * 256 + threadIdx.x; i < n; i += (size_t)gridDim.x * 256) { const float v = bf_lo(p[i]); if (!(fabsf(v) < 1e30f)) bad = true; }
    if (bad) atomicOr(flags, bit);
}
__global__ void diag_final(float* out, size_t n, const unsigned* flags) {
    const unsigned f = *flags;
    for (size_t i = (size_t)blockIdx.x * 256 + threadIdx.x; i < n; i += (size_t)gridDim.x * 256) { float v = out[i]; if (!(fabsf(v) < 1e30f)) v = 500.f; if (i == 0 && f) v = 1000.f * (float)f; out[i] = v; }
}
#endif
__global__ void __launch_bounds__(512) mega_fwd(Args a) {
    extern __shared__ __attribute__((aligned(16))) unsigned char lds_raw[];
    LAS unsigned char* L = (LAS unsigned char*)lds_raw;
    float* MOD = (float*)(a.ws + WS_MOD); float* Hs = (float*)(a.ws + WS_H);
    volatile LAS unsigned* bst = (volatile LAS unsigned*)(L + LDS_BYTES - 64);
    if (threadIdx.x == 0) { bst[0] = 0u; bst[1] = 0u; }
    __syncthreads();
    const XcdBarrier xbar = xcd_barrier_post((unsigned*)(a.ws + WS_BAR), bst);
    bf16_t* ABUF = (bf16_t*)(a.ws + WS_ABUF);
#ifdef DUP_MASK
    const int nsteps_tot = (a.ph_hi - a.ph_lo) + 2 * __builtin_popcount(DUP_MASK);
#else
    const int nsteps_tot = a.ph_hi - a.ph_lo;
#endif
    int ph = a.ph_lo - 1, duprep = 0;
    for (int st = 0; st < nsteps_tot; ++st) {
#ifdef DUP_MASK
        if (duprep == 0 && ph >= a.ph_lo && ph < 20 && ((DUP_MASK >> (ph % 10)) & 1)) duprep = 1; else { duprep = 0; ++ph; }
#else
        ++ph;
#endif
        if (ph > a.ph_lo && duprep == 0) { if (a.ph_hi > 1000) cg::this_grid().sync(); else xcd_barrier(xbar); }
        int tid_opq = threadIdx.x; asm volatile("" : "+v"(tid_opq));
        const int tid = tid_opq, lane = tid & 63, wave = __builtin_amdgcn_readfirstlane(tid >> 6);
        const int gw = blockIdx.x * 8 + wave, NGW = gridDim.x * 8;
        if (ph == 20) { final_norm_phase(a.out, a.in[18], gw, NGW, lane); continue; }
        const int l = ph / 10, p = ph % 10;
        const float* xsrc = (l == 0) ? a.in[0] : a.out; const float* hsrc = (l == 0) ? a.in[2] : Hs;
        const int Mrows = (l == 0) ? MT : MX;
        if (p == 0 && PH_ON(0)) p0_phase(a, l, L, tid, lane, wave);
        else if (p == 1 && PH_ON(1)) norm_phase(xsrc, hsrc, (l == 1) ? (const float*)(a.ws + WS_XG) : nullptr, MT, a.in[6] + (size_t)l * DM, MOD, 0, ABUF, gw, NGW, lane);
        else if (p == 2 && PH_ON(2)) {
            pg8::Gemm g{ABUF, (const bf16_t*)(a.ws + WS_WIN), MT, 5376, 2048, 2048}; pg8::StaticOrder S; S.init(MT, 5376, (int)gridDim.x, (int)blockIdx.x);
            EpiProj E{(bf16_t*)(a.ws + WS_PROJ)};
            if (l == 0) pg8::gemm_phase<EpiProj, pg8::StaticOrder, true, true>(L, g, S, E);
            else { L1Order S1; S1.init((int)gridDim.x, (int)blockIdx.x); pg8::gemm_phase<EpiProj, L1Order, true, true>(L, g, S1, E); }
        }
        else if (p == 3 && PH_ON(3)) prep_phase(a, l, L, tid, lane, wave);
        else if (p == 4 && PH_ON(4)) {
            xinv_phase(a, l, L, tid, wave);
            asm volatile("s_waitcnt vmcnt(0)" ::: "memory"); __syncthreads();
            scan_phase(a, l, L, tid, lane, wave);
        }
        else if (p == 5 && PH_ON(5)) gate_phase(a, l, Mrows, gw, NGW, lane);
        else if (p == 6 && PH_ON(6)) {
            pg8::Gemm g{ABUF, (const bf16_t*)(a.ws + WS_WOUT), Mrows, 2048, 2048, 2048}; pg8::StaticOrder S; S.init(Mrows, 2048, (int)gridDim.x, (int)blockIdx.x);
            EpiRes E{xsrc, a.out, hsrc, Hs, MOD + 2 * 2048};
            pg8::gemm_phase<EpiRes, pg8::StaticOrder, true, true>(L, g, S, E);
        }
        else if (p == 7 && PH_ON(7)) norm_phase(a.out, Hs, nullptr, Mrows, a.in[7] + (size_t)l * DM, MOD, 3, ABUF, gw, NGW, lane);
        else if (p == 8 && PH_ON(8)) {
            pg8::Gemm g{ABUF, (const bf16_t*)(a.ws + WS_WUP), Mrows, 8192, 2048, 2048}; pg8::StaticOrder S; S.init(Mrows, 8192, (int)gridDim.x, (int)blockIdx.x);
            EpiUp E{(bf16_t*)(a.ws + WS_HID)};
            pg8::gemm_phase<EpiUp, pg8::StaticOrder, true, true>(L, g, S, E);
        }
        else if (PH_ON(9)) {
            pg8::Gemm g{(const bf16_t*)(a.ws + WS_HID), (const bf16_t*)(a.ws + WS_WDN), MX, 2048, 8192, 8192}; pg8::StaticOrder S; S.init(MX, 2048, (int)gridDim.x, (int)blockIdx.x);
            EpiRes E{a.out, a.out, Hs, Hs, MOD + 5 * 2048};
            pg8::gemm_phase<EpiRes, pg8::StaticOrder, true, true>(L, g, S, E);
            if (l == 0) {
                pg8::Gemm g2{(const bf16_t*)(a.ws + WS_HID) + (size_t)MX * DFF, (const bf16_t*)(a.ws + WS_WDN), MH, 2048, 4096, 8192}; CtxSplitOrder S2{(int)gridDim.x, (int)blockIdx.x};
                EpiCtxSplit E2{Hs, (float*)(a.ws + WS_XG), MOD + (size_t)16 * 12288 + 5 * 2048};
                pg8::gemm_phase<EpiCtxSplit, CtxSplitOrder, true, true>(L, g2, S2, E2);
            }
        }
    }
}

extern "C" void kernel_launch(void* const* d_in, const int* in_sizes, int n_in, void* d_out, int out_size, void* d_ws, size_t ws_size, hipStream_t stream) {
    static int grid = 0;
    if (grid == 0) {
        if (n_in != 19 || ws_size < WS_END) { fprintf(stderr, "kernel_launch: unexpected inputs (n_in %d, ws %zu < %zu)\n", n_in, ws_size, (size_t)WS_END); grid = -1; return; }
        int dev = 0, cus = 0, per_cu = 0;
        hipGetDevice(&dev); hipDeviceGetAttribute(&cus, hipDeviceAttributeMultiprocessorCount, dev);
        if (hipFuncSetAttribute((const void*)mega_fwd, hipFuncAttributeMaxDynamicSharedMemorySize, LDS_BYTES) != hipSuccess) { fprintf(stderr, "kernel_launch: hipFuncSetAttribute failed\n"); grid = -1; return; }
        if (hipOccupancyMaxActiveBlocksPerMultiprocessor(&per_cu, (const void*)mega_fwd, 512, LDS_BYTES) != hipSuccess || per_cu < 1) { fprintf(stderr, "kernel_launch: occupancy query says %d\n", per_cu); per_cu = 1; }
        (void)hipGetLastError();
        grid = cus * 1;
    }
    if (grid < 0) return;
    Args a{};
    for (int i = 0; i < 19; ++i) a.in[i] = (const float*)d_in[i];
    a.out = (float*)d_out; a.ws = (unsigned char*)d_ws;
#if PER_PHASE_LAUNCH
    for (int ph = 0; ph < 23; ++ph) {
#if DIAG
        unsigned* flags = (unsigned*)(a.ws + WS_FLAGS);
        if (ph == 0) hipLaunchKernelGGL(diag_zero, dim3(1), dim3(64), 0, stream, flags);
        if (ph == 1) hipLaunchKernelGGL(diag_f32, dim3(1024), dim3(256), 0, stream, (const float*)(a.ws + WS_MOD), (size_t)17 * 12288, 1u, flags);
        if (ph == 3) hipLaunchKernelGGL(diag_bf16, dim3(1024), dim3(256), 0, stream, (const bf16_t*)(a.ws + WS_PROJ), (size_t)MT * NPROJ, 2u, flags);
        if (ph == 4) { hipLaunchKernelGGL(diag_bf16, dim3(1024), dim3(256), 0, stream, (const bf16_t*)(a.ws + WS_Q), (size_t)MT * 1024 * 3, 4u, flags);
                       hipLaunchKernelGGL(diag_bf16, dim3(1024), dim3(256), 0, stream, (const bf16_t*)(a.ws + WS_ABUF), (size_t)MT * 2048, 4u, flags); }
        if (ph == 5) hipLaunchKernelGGL(diag_bf16, dim3(1024), dim3(256), 0, stream, (const bf16_t*)(a.ws + WS_OB), (size_t)MT * 1024, 8u, flags);
        if (ph == 6) hipLaunchKernelGGL(diag_bf16, dim3(1024), dim3(256), 0, stream, (const bf16_t*)(a.ws + WS_ABUF), (size_t)MT * 2048, 16u, flags);
        if (ph == 10) { hipLaunchKernelGGL(diag_f32, dim3(1024), dim3(256), 0, stream, (const float*)a.out, (size_t)MX * DM, 32u, flags);
                        hipLaunchKernelGGL(diag_f32, dim3(1024), dim3(256), 0, stream, (const float*)(a.ws + WS_H), (size_t)MH * DM, 32u, flags); }
#endif
        a.ph_lo = ph; a.ph_hi = ph + 1; hipLaunchKernelGGL(mega_fwd, dim3(grid), dim3(512), LDS_BYTES, stream, a);
    }
#if DIAG
    hipLaunchKernelGGL(diag_final, dim3(1024), dim3(256), 0, stream, a.out, (size_t)MX * DM, (const unsigned*)(a.ws + WS_FLAGS));
#endif
#else
    a.ph_lo = 0; a.ph_hi = 21;
    (void)hipMemsetAsync((char*)d_ws + WS_BAR, 0, XCD_BAR_WORDS * 4, stream);
    void* kargs[] = {&a};
    hipError_t e = hipLaunchCooperativeKernel((const void*)mega_fwd, dim3(grid), dim3(512), kargs, LDS_BYTES, stream);
    if (e != hipSuccess) fprintf(stderr, "kernel_launch: cooperative launch failed: %s (grid %d)\n", hipGetErrorString(e), grid);
#endif
}
```
